# Optimizing an MI355X kernel written in HIP

```python
import jax, jax.numpy as jnp
from jax import lax
import numpy as np

D_MODEL = 2048
BATCH = 4
SEQ = 4096
DEPTH = 2

MEM_LEN = 256
EPS = 1e-6
HEAD_DIM = 64
N_Q_HEADS = 16
N_KV_HEADS = 2
Q_PER_KV = N_Q_HEADS // N_KV_HEADS
ATTN_WIDTH = N_Q_HEADS * HEAD_DIM
KV_WIDTH = N_KV_HEADS * HEAD_DIM
WINDOW = 128
BLOCK = 128
ROPE_DIM = HEAD_DIM // 4
ROPE_THETA = 500000.0
SGU_GROUPS = 8
SGU_WIDTH = D_MODEL // 2
SGU_GROUP_DIM = SGU_WIDTH // SGU_GROUPS
CHUNK = 128
IN_WIDTH = ATTN_WIDTH + 2 * KV_WIDTH + 2 * SGU_WIDTH
MIX_WIDTH = ATTN_WIDTH + SGU_WIDTH
POOL_WINDOWS = (2, 4, 8, 16)
N_POOL_GROUPS = len(POOL_WINDOWS)
POOL_GROUP_DIM = D_MODEL // N_POOL_GROUPS
X_HEADS = 4
X_HEAD_DIM = 128
X_WIDTH = X_HEADS * X_HEAD_DIM
D_FF = 5632
N_NORMS = 8
N_EVEN = (DEPTH + 1) // 2
N_ODD = DEPTH // 2

kernel_name = "hybrid_swa_sgu_pool_macaron"


def rms_norm(x, g):
    xf = x.astype(jnp.float32)
    y = xf * lax.rsqrt(jnp.mean(xf * xf, axis=-1, keepdims=True) + EPS)
    return (y * g.astype(jnp.float32)).astype(x.dtype)


def swiglu(h, wg, wu, wd):
    return (jax.nn.silu(h @ wg) * (h @ wu)) @ wd


def rope_tables(seq):
    half = ROPE_DIM // 2
    inv = ROPE_THETA ** (-jnp.arange(half, dtype=jnp.float32) * 2.0 / ROPE_DIM)
    ang = jnp.arange(seq, dtype=jnp.float32)[:, None] * inv[None, :]
    return jnp.cos(ang)[:, None, :], jnp.sin(ang)[:, None, :]


def partial_rope(x, cos, sin):
    xf = x.astype(jnp.float32)
    half = ROPE_DIM // 2
    x1 = xf[..., :half]
    x2 = xf[..., half:ROPE_DIM]
    rot = jnp.concatenate([x1 * cos - x2 * sin, x2 * cos + x1 * sin, xf[..., ROPE_DIM:]], axis=-1)
    return rot.astype(x.dtype)


def swa_sink_attention(q, k, v, sinks):
    b, s = q.shape[0], q.shape[1]
    nb = s // BLOCK
    qb = q.reshape(b, nb, BLOCK, N_KV_HEADS, Q_PER_KV, HEAD_DIM)
    pad = ((0, 0), (BLOCK, 0), (0, 0), (0, 0))
    kp = jnp.pad(k, pad).reshape(b, nb + 1, BLOCK, N_KV_HEADS, HEAD_DIM)
    vp = jnp.pad(v, pad).reshape(b, nb + 1, BLOCK, N_KV_HEADS, HEAD_DIM)
    kb = jnp.concatenate([kp[:, :-1], kp[:, 1:]], axis=2)
    vb = jnp.concatenate([vp[:, :-1], vp[:, 1:]], axis=2)
    scores = jnp.einsum('bnqhgd,bnkhd->bnhgqk', qb, kb,
                        preferred_element_type=jnp.float32) * (HEAD_DIM ** -0.5)
    qi = jnp.arange(BLOCK)[:, None]
    kj = jnp.arange(2 * BLOCK)[None, :]
    rel = qi + BLOCK - kj
    band = (rel >= 0) & (rel < WINDOW)
    not_pad = (jnp.arange(nb)[:, None, None] > 0) | (kj >= BLOCK)[None]
    valid = band[None] & not_pad
    scores = jnp.where(valid[None, :, None, None], scores, jnp.float32(-1e30))
    sink = jnp.broadcast_to(
        sinks.astype(jnp.float32).reshape(N_KV_HEADS, Q_PER_KV)[None, None, :, :, None, None],
        scores.shape[:-1] + (1,))
    probs = jax.nn.softmax(jnp.concatenate([scores, sink], axis=-1), axis=-1)[..., :-1]
    out = jnp.einsum('bnhgqk,bnkhd->bnqhgd', probs.astype(v.dtype), vb)
    return out.reshape(b, s, ATTN_WIDTH)


def chunked_spatial_gating(u, v, ln_g, ln_b, w_s, b_s):
    b, s = u.shape[0], u.shape[1]
    nc = s // CHUNK
    vf = v.astype(jnp.float32)
    mu = jnp.mean(vf, axis=-1, keepdims=True)
    var = jnp.mean(jnp.square(vf - mu), axis=-1, keepdims=True)
    vn = ((vf - mu) * lax.rsqrt(var + EPS) * ln_g.astype(jnp.float32) + ln_b.astype(jnp.float32)).astype(v.dtype)
    vc = vn.reshape(b, nc, CHUNK, SGU_GROUPS, SGU_GROUP_DIM)
    causal = jnp.tril(jnp.ones((CHUNK, CHUNK), dtype=w_s.dtype))
    mixed = jnp.einsum('gij,bnjgc->bnigc', w_s * causal[None], vc) \
        + jnp.transpose(b_s)[None, None, :, :, None]
    return u * mixed.reshape(b, s, SGU_WIDTH).astype(u.dtype)


def attn_sgu_mixer(h, w_in, w_out, sinks, ln_g, ln_b, w_s, b_s, cos, sin):
    b, s = h.shape[0], h.shape[1]
    z = h @ w_in
    o1 = ATTN_WIDTH
    o2 = o1 + KV_WIDTH
    o3 = o2 + KV_WIDTH
    o4 = o3 + SGU_WIDTH
    q = partial_rope(z[..., :o1].reshape(b, s, N_Q_HEADS, HEAD_DIM), cos, sin)
    k = partial_rope(z[..., o1:o2].reshape(b, s, N_KV_HEADS, HEAD_DIM), cos, sin)
    v = z[..., o2:o3].reshape(b, s, N_KV_HEADS, HEAD_DIM)
    attn = swa_sink_attention(q, k, v, sinks)
    gate = chunked_spatial_gating(jax.nn.gelu(z[..., o3:o4]), jax.nn.gelu(z[..., o4:]), ln_g, ln_b, w_s, b_s)
    return jnp.concatenate([attn, gate], axis=-1) @ w_out


def multiscale_pool_mixer(h, pool_w, pool_scale):
    b, s = h.shape[0], h.shape[1]
    hf = h.astype(jnp.float32).reshape(b, s, N_POOL_GROUPS, POOL_GROUP_DIM)
    cs = jnp.cumsum(hf, axis=1)
    count = jnp.arange(1, s + 1, dtype=jnp.float32)
    outs = []
    for gi, w in enumerate(POOL_WINDOWS):
        c = cs[:, :, gi]
        prev = jnp.pad(c, ((0, 0), (w, 0), (0, 0)))[:, :s]
        mean = (c - prev) / jnp.minimum(count, jnp.float32(w))[None, :, None]
        outs.append(mean - hf[:, :, gi])
    pooled = jnp.stack(outs, axis=2).astype(h.dtype)
    y = jnp.einsum('bsgc,gcd->bsgd', pooled, pool_w).reshape(b, s, D_MODEL)
    return y * pool_scale


def memory_cross_attention(h, mem_n, wq, wk, wv, wo):
    b, s = h.shape[0], h.shape[1]
    m = mem_n.shape[1]
    q = (h @ wq).reshape(b, s, X_HEADS, X_HEAD_DIM)
    k = (mem_n @ wk).reshape(b, m, X_HEADS, X_HEAD_DIM)
    v = (mem_n @ wv).reshape(b, m, X_HEADS, X_HEAD_DIM)
    sc = jnp.einsum('bshd,bmhd->bhsm', q, k, preferred_element_type=jnp.float32) * (X_HEAD_DIM ** -0.5)
    p = jax.nn.softmax(sc, axis=-1)
    o = jnp.einsum('bhsm,bmhd->bshd', p.astype(v.dtype), v).reshape(b, s, X_WIDTH)
    return o @ wo


def setup_inputs(seed: int = 0) -> dict:
    key = jax.random.key(seed)
    ks = jax.random.split(key, 24)
    f32 = jnp.float32

    def w(k, shape, fan_in):
        return jax.random.normal(k, shape, f32) * (fan_in ** -0.5)

    return {
        "x": jax.random.normal(ks[0], (BATCH, SEQ, D_MODEL), f32),
        "mem": jax.random.normal(ks[1], (BATCH, MEM_LEN, D_MODEL), f32),
        "norms": 1.0 + 0.1 * jax.random.normal(ks[2], (DEPTH, N_NORMS, D_MODEL), f32),
        "mem_norm": 1.0 + 0.1 * jax.random.normal(ks[3], (DEPTH, D_MODEL), f32),
        "ffn1_wg": w(ks[4], (DEPTH, D_MODEL, D_FF), D_MODEL),
        "ffn1_wu": w(ks[5], (DEPTH, D_MODEL, D_FF), D_MODEL),
        "ffn1_wd": w(ks[6], (DEPTH, D_FF, D_MODEL), D_FF),
        "ffn2_wg": w(ks[7], (DEPTH, D_MODEL, D_FF), D_MODEL),
        "ffn2_wu": w(ks[8], (DEPTH, D_MODEL, D_FF), D_MODEL),
        "ffn2_wd": w(ks[9], (DEPTH, D_FF, D_MODEL), D_FF),
        "x_wq": w(ks[10], (DEPTH, D_MODEL, X_WIDTH), D_MODEL),
        "x_wk": w(ks[11], (DEPTH, D_MODEL, X_WIDTH), D_MODEL),
        "x_wv": w(ks[12], (DEPTH, D_MODEL, X_WIDTH), D_MODEL),
        "x_wo": w(ks[13], (DEPTH, X_WIDTH, D_MODEL), X_WIDTH),
        "mix_w_in": w(ks[14], (N_EVEN, D_MODEL, IN_WIDTH), D_MODEL),
        "mix_w_out": w(ks[15], (N_EVEN, MIX_WIDTH, D_MODEL), MIX_WIDTH),
        "attn_sinks": 0.5 * jax.random.normal(ks[16], (N_EVEN, N_Q_HEADS), f32),
        "sgu_ln_g": 1.0 + 0.1 * jax.random.normal(ks[17], (N_EVEN, SGU_WIDTH), f32),
        "sgu_ln_b": 0.02 * jax.random.normal(ks[18], (N_EVEN, SGU_WIDTH), f32),
        "sgu_w": w(ks[19], (N_EVEN, SGU_GROUPS, CHUNK, CHUNK), CHUNK),
        "sgu_b": 1.0 + 0.1 * jax.random.normal(ks[20], (N_EVEN, SGU_GROUPS, CHUNK), f32),
        "pool_w": w(ks[21], (N_ODD, N_POOL_GROUPS, POOL_GROUP_DIM, POOL_GROUP_DIM), POOL_GROUP_DIM),
        "pool_scale": 1.0 + 0.2 * jax.random.normal(ks[22], (N_ODD, D_MODEL), f32),
    }


def reference(x, mem, norms, mem_norm, ffn1_wg, ffn1_wu, ffn1_wd, ffn2_wg, ffn2_wu, ffn2_wd,
              x_wq, x_wk, x_wv, x_wo, mix_w_in, mix_w_out, attn_sinks, sgu_ln_g, sgu_ln_b,
              sgu_w, sgu_b, pool_w, pool_scale):
    cos, sin = rope_tables(x.shape[1])
    for layer in range(DEPTH):
        g = norms[layer]
        h = rms_norm(x, g[0])
        x = x + 0.5 * rms_norm(swiglu(h, ffn1_wg[layer], ffn1_wu[layer], ffn1_wd[layer]), g[1])
        h = rms_norm(x, g[2])
        i = layer // 2
        if layer % 2 == 0:
            m = attn_sgu_mixer(h, mix_w_in[i], mix_w_out[i], attn_sinks[i], sgu_ln_g[i], sgu_ln_b[i],
                               sgu_w[i], sgu_b[i], cos, sin)
        else:
            m = multiscale_pool_mixer(h, pool_w[i], pool_scale[i])
        x = x + rms_norm(m, g[3])
        h = rms_norm(x, g[4])
        mem_n = rms_norm(mem, mem_norm[layer])
        x = x + rms_norm(memory_cross_attention(h, mem_n, x_wq[layer], x_wk[layer], x_wv[layer], x_wo[layer]), g[5])
        h = rms_norm(x, g[6])
        x = x + 0.5 * rms_norm(swiglu(h, ffn2_wg[layer], ffn2_wu[layer], ffn2_wd[layer]), g[7])
    return x
```

```cpp
#include <hip/hip_runtime.h>
#include <hip/hip_cooperative_groups.h>
#include <cstdio>
#include <cstdint>
#include <cmath>
namespace cg = cooperative_groups;

#define LAS __attribute__((address_space(3)))
#define GAS __attribute__((address_space(1)))
typedef unsigned short bf16_t;
typedef short bf16x8 __attribute__((ext_vector_type(8)));
typedef short s16x4 __attribute__((ext_vector_type(4)));
typedef float f32x4 __attribute__((ext_vector_type(4)));
typedef float f32x2 __attribute__((ext_vector_type(2)));
typedef unsigned u32x4 __attribute__((ext_vector_type(4)));
typedef unsigned u32x2 __attribute__((ext_vector_type(2)));

constexpr int MTOK = 16384, DM = 2048, DFF = 5632, SEQ = 4096, MEMROWS = 1024;
constexpr int INW = 3328;
constexpr float EPS = 1e-6f;

constexpr size_t MiB = 1u << 20;
constexpr size_t WS_CNT  = 16384;
constexpr size_t WS_ROPE = 1 * MiB;
constexpr size_t WS_XB   = 2 * MiB;
constexpr size_t WS_RS   = 3 * MiB;
constexpr size_t WS_SST  = 4 * MiB;
constexpr size_t WS_SGUW = 6 * MiB;
constexpr size_t WS_MEMN = 8 * MiB;
constexpr size_t WS_Q    = 16 * MiB;
constexpr size_t WS_O    = 32 * MiB;
constexpr size_t WS_KV   = 48 * MiB;
constexpr size_t WS_H    = 64 * MiB;
constexpr size_t WS_HID  = 128 * MiB;
constexpr size_t WS_Z    = 128 * MiB;
constexpr size_t WS_CAT  = 232 * MiB;
constexpr size_t WS_POOL = 128 * MiB;
constexpr size_t WS_WL   = 304 * MiB;
constexpr size_t WL_STRIDE = 164 * MiB;
constexpr size_t WO_W1A = 0, WO_W1D = 44 * MiB, WO_W2A = 66 * MiB, WO_W2D = 110 * MiB, WO_WQ = 132 * MiB, WO_WKV = 134 * MiB, WO_WO = 138 * MiB,
                 WO_WIN = 140 * MiB, WO_WOUT = 154 * MiB, WO_WPOOL = 140 * MiB;
constexpr size_t WS_END  = WS_WL + 2 * WL_STRIDE;

constexpr int LDS_BYTES = 147456;
constexpr int XL_OFF = 131072;

typedef __bf16 bf16x2_t __attribute__((ext_vector_type(2)));
__device__ __forceinline__ unsigned cvt_pk_bf16(float lo, float hi) { const f32x2 v = {lo, hi}; const bf16x2_t b = __builtin_convertvector(v, bf16x2_t); return __builtin_bit_cast(unsigned, b); }
__device__ __forceinline__ float bflo(unsigned w) { return __uint_as_float(w << 16); }
__device__ __forceinline__ float bfhi(unsigned w) { return __uint_as_float(w & 0xffff0000u); }
__device__ __forceinline__ float wave_sum(float v) {
#pragma unroll
    for (int o = 1; o < 64; o <<= 1) v += __shfl_xor(v, o);
    return v;
}
__device__ __forceinline__ float gelu_tanh(float x) {
    const float inner = 1.5957691216057308f * (x + 0.044715f * x * x * x);
    return x * __builtin_amdgcn_rcpf(1.0f + __expf(-inner));
}
__device__ __forceinline__ float silu_f(float x) { return x * __builtin_amdgcn_rcpf(1.0f + __expf(-x)); }
__device__ __forceinline__ int fresh_tid() { int t = threadIdx.x; asm volatile("" : "+v"(t)); return t; }
__device__ __forceinline__ float row_rs(const float* rsp, int row) {
    const f32x4 a = *(const GAS f32x4*)((const GAS float*)rsp + (size_t)row * 8), b = *(const GAS f32x4*)((const GAS float*)rsp + (size_t)row * 8 + 4);
    return __builtin_amdgcn_rsqf((((a[0] + a[1]) + (a[2] + a[3])) + ((b[0] + b[1]) + (b[2] + b[3]))) * (1.0f / DM) + EPS);
}
constexpr int RS_TABLE_UNITS = 15;
__device__ __forceinline__ float rs_lookup(const LAS float* T, const float* rsp, int ord, int pm, int lrow) {
    return (ord < RS_TABLE_UNITS) ? T[ord * 256 + lrow] : row_rs(rsp, pm * 256 + lrow);
}
__device__ __forceinline__ void rs_lookup8(float (&rsv)[8], const LAS float* T, const float* rsp, int ord, int pm, int lrow0) {
    if (ord < RS_TABLE_UNITS) {
#pragma unroll
        for (int q = 0; q < 8; ++q) rsv[q] = T[ord * 256 + lrow0 + (q >> 2) * 128 + (q & 3) * 16];
    } else {
#pragma unroll
        for (int q = 0; q < 8; ++q) rsv[q] = row_rs(rsp, pm * 256 + lrow0 + (q >> 2) * 128 + (q & 3) * 16);
    }
}
#define MFMA16(a, b, c) __builtin_amdgcn_mfma_f32_16x16x32_bf16((a), (b), (c), 0, 0, 0)

namespace pg8 {
constexpr int BM = 256, BK = 64, HALF = 128, HTB = HALF * BK * 2, STAGE_BYTES = 8 * HTB, NXCD = 8, WGM = 8;
__host__ __device__ __forceinline__ int lds_byte(int r, int c) { const int st = (r >> 4) * 2 + (c >> 5), rr = r & 15, cc = c & 31, ob = rr * 64 + cc * 2; return st * 1024 + (ob ^ (((ob >> 9) & 1) << 5)); }
__host__ __device__ __forceinline__ void stage_rc(int b, int& R, int& C) { const int st = b / 1024, sb = b % 1024, swz = sb ^ (((sb >> 9) & 1) << 5); R = (st >> 1) * 16 + swz / 64; C = (st & 1) * 32 + (swz % 64) / 2; }
__host__ __device__ __forceinline__ int perm32(int rho) { const int n = rho >> 4, i = rho & 15; return 8 * (i >> 2) + 4 * n + (i & 3); }

struct Unit { int pm, pn, ord; };
struct Gemm { const bf16_t* A; const bf16_t* Bt; int M, N, K, lda, ldb, a_shift; unsigned a_stride; };

struct StaticOrder {
    int nM, nN, nwg, G, c;
    __device__ void init(int M, int N, int G_, int c_) { nM = M / BM; nN = N / BM; nwg = nM * nN; G = G_; c = c_; }
    __device__ bool next(int i, Unit& u) const {
        const long L = (long)i * G + c; if (L >= nwg) return false;
        int wgid = (int)L; { const int q = nwg / NXCD, r = nwg % NXCD, xcd = wgid % NXCD, off = wgid / NXCD; wgid = (xcd < r ? xcd * (q + 1) : r * (q + 1) + (xcd - r) * q) + off; }
        const int nig = WGM * nN, gid = wgid / nig, fm = gid * WGM, gsz = (nM - fm) < WGM ? (nM - fm) : WGM;
        u.pm = fm + ((wgid % nig) % gsz); u.pn = (wgid % nig) / gsz; return true;
    }
};


struct EpiAct {
    bf16_t* O; int ldc; int gelu_from, stat_from; f32x2* st;
    const float* rs; const LAS float* T;
    __device__ __forceinline__ void operator()(const f32x4 (&acc)[2][2][4][2], const Unit& u, int wr, int wc, int fr, int fq) const {
        const int row0 = u.pm * BM + wr * 64 + fr, col0 = u.pn * BM + wc * 32 + 8 * fq;
        const bool do_gelu = u.pn >= gelu_from, do_stat = u.pn >= stat_from;
        float rsv8[8];
        if (rs) rs_lookup8(rsv8, T, rs, u.ord, u.pm, wr * 64 + fr);
        else {
#pragma unroll
            for (int q = 0; q < 8; ++q) rsv8[q] = 1.0f;
        }
#pragma unroll
        for (int ai = 0; ai < 2; ++ai)
#pragma unroll
            for (int m = 0; m < 4; ++m) {
                const int row = row0 + ai * HALF + m * 16;
                GAS bf16_t* rowp = (GAS bf16_t*)O + (size_t)row * ldc + col0;
                const float rsv = rsv8[ai * 4 + m];
                float s1 = 0.f, s2 = 0.f;
#pragma unroll
                for (int bj = 0; bj < 2; ++bj) {
                    f32x4 v0 = acc[ai][bj][m][0] * rsv, v1 = acc[ai][bj][m][1] * rsv;
                    if (do_gelu) {
#pragma unroll
                        for (int e = 0; e < 4; ++e) { v0[e] = gelu_tanh(v0[e]); v1[e] = gelu_tanh(v1[e]); }
                    }
                    if (do_stat) {
#pragma unroll
                        for (int e = 0; e < 4; ++e) { s1 += v0[e] + v1[e]; s2 += v0[e] * v0[e] + v1[e] * v1[e]; }
                    }
                    u32x4 w; w.x = cvt_pk_bf16(v0[0], v0[1]); w.y = cvt_pk_bf16(v0[2], v0[3]); w.z = cvt_pk_bf16(v1[0], v1[1]); w.w = cvt_pk_bf16(v1[2], v1[3]);
                    *(GAS u32x4*)(rowp + bj * HALF) = w;
                }
                if (do_stat) {
                    s1 += __shfl_xor(s1, 16); s1 += __shfl_xor(s1, 32); s2 += __shfl_xor(s2, 16); s2 += __shfl_xor(s2, 32);
                    if (fq == 0) ((GAS f32x2*)st)[(size_t)((u.pn - stat_from) * 4 + wc) * MTOK + row] = (f32x2){s1, s2};
                }
            }
    }
};
struct EpiHalf {
    bf16_t* O; int ldc; const float* rs; const LAS float* T;
    __device__ __forceinline__ void operator()(const f32x4 (&acc)[2][2][4][2], const Unit& u, int wr, int wc, int fr, int fq) const {
        const int row0 = u.pm * BM + wr * 64 + fr, col0 = u.pn * HALF + wc * 32 + 8 * fq;
        float rsv8[8];
        rs_lookup8(rsv8, T, rs, u.ord, u.pm, wr * 64 + fr);
#pragma unroll
        for (int ai = 0; ai < 2; ++ai)
#pragma unroll
            for (int m = 0; m < 4; ++m) {
                const int row = row0 + ai * HALF + m * 16;
                const float rsv = rsv8[ai * 4 + m];
                const f32x4 v0 = acc[ai][0][m][0] * rsv, v1 = acc[ai][0][m][1] * rsv;
                u32x4 w; w.x = cvt_pk_bf16(v0[0], v0[1]); w.y = cvt_pk_bf16(v0[2], v0[3]); w.z = cvt_pk_bf16(v1[0], v1[1]); w.w = cvt_pk_bf16(v1[2], v1[3]);
                *(GAS u32x4*)((GAS bf16_t*)O + (size_t)row * ldc + col0) = w;
            }
    }
};
struct EpiSwiglu {
    bf16_t* O; const float* rs; const LAS float* T;
    __device__ __forceinline__ void operator()(const f32x4 (&acc)[2][2][4][2], const Unit& u, int wr, int wc, int fr, int fq) const {
        const int row0 = u.pm * BM + wr * 64 + fr, col0 = u.pn * HALF + wc * 32 + 8 * fq;
        float rsv[8], irs2[8];
        rs_lookup8(rsv, T, rs, u.ord, u.pm, wr * 64 + fr);
#pragma unroll
        for (int q = 0; q < 8; ++q) irs2[q] = __builtin_amdgcn_rcpf(rsv[q] * rsv[q]);
#pragma unroll
        for (int ai = 0; ai < 2; ++ai)
#pragma unroll
            for (int mp = 0; mp < 2; ++mp) {
                f32x2 gg[8], ee[8];
#pragma unroll
                for (int q = 0; q < 8; ++q) {
                    const int m = 2 * mp + (q >> 2), n = (q >> 1) & 1, h2 = q & 1;
                    gg[q] = (f32x2){acc[ai][0][m][n][2 * h2], acc[ai][0][m][n][2 * h2 + 1]};
                    const f32x2 a2 = gg[q] * (rsv[ai * 4 + m] * -1.4426950408889634f);
                    ee[q].x = __builtin_amdgcn_exp2f(a2.x); ee[q].y = __builtin_amdgcn_exp2f(a2.y);
                }
#pragma unroll
                for (int q = 0; q < 8; ++q) { const float ir = irs2[ai * 4 + 2 * mp + (q >> 2)]; const f32x2 d2 = ee[q] * ir + ir;
                    ee[q].x = __builtin_amdgcn_rcpf(d2.x); ee[q].y = __builtin_amdgcn_rcpf(d2.y); }
                u32x4 w[2];
#pragma unroll
                for (int q = 0; q < 8; ++q) {
                    const int m = 2 * mp + (q >> 2), n = (q >> 1) & 1, h2 = q & 1;
                    const f32x2 u2 = {acc[ai][1][m][n][2 * h2], acc[ai][1][m][n][2 * h2 + 1]};
                    const f32x2 o2 = (gg[q] * u2) * ee[q];
                    w[q >> 2][(q & 3)] = cvt_pk_bf16(o2.x, o2.y);
                }
#pragma unroll
                for (int k = 0; k < 2; ++k) *(GAS u32x4*)((GAS bf16_t*)O + (size_t)(row0 + ai * HALF + (2 * mp + k) * 16) * DFF + col0) = w[k];
            }
    }
};
struct PanelOrder {
    int nwg, G, vcu;
    __device__ void init(int M, int G_, int c_) { nwg = (M / BM) * 8; G = G_; vcu = (c_ % 8) * (G_ / 8) + c_ / 8; }
    __device__ bool next(int i, Unit& u) const { const long L = (long)i * G + vcu; if (L >= nwg) return false; u.pm = (int)(L >> 3); u.pn = (int)(L & 7); return true; }
};
struct EpiNorm {
    bf16_t* XB; float* OUT; float* rs; const float* g_post; float wgt;
    float* xb; unsigned* cnt; unsigned want; LAS unsigned char* xl;
    __device__ __forceinline__ void exchange_post(const f32x4 (&v)[2][2][4][2], const Unit& u, int wr, int wc, int fr, int fq, int wid, int lane, int which) const {
        LAS float* P = (LAS float*)xl;
#pragma unroll
        for (int ai = 0; ai < 2; ++ai)
#pragma unroll
            for (int m = 0; m < 4; ++m) {
                float q = 0.f;
#pragma unroll
                for (int bj = 0; bj < 2; ++bj)
#pragma unroll
                    for (int n = 0; n < 2; ++n) { const f32x4 x = v[ai][bj][m][n]; q += (x[0] * x[0] + x[1] * x[1]) + (x[2] * x[2] + x[3] * x[3]); }
                q += __shfl_xor(q, 16); q += __shfl_xor(q, 32);
                if (fq == 0) P[(ai * HALF + wr * 64 + m * 16 + fr) * 4 + wc] = q;
            }
        asm volatile("s_waitcnt lgkmcnt(0)" ::: "memory"); __builtin_amdgcn_s_barrier(); asm volatile("" ::: "memory");
        const int row = wid * 32 + (lane & 31);
        unsigned long long* slots = (unsigned long long*)xb + ((size_t)u.pm * BM + row) * 8;
        if (lane < 32) {
            const float t = (P[row * 4 + 0] + P[row * 4 + 1]) + (P[row * 4 + 2] + P[row * 4 + 3]);
            __hip_atomic_store(slots + u.pn, ((unsigned long long)want << 32) | (unsigned long long)__float_as_uint(t), __ATOMIC_RELAXED, __HIP_MEMORY_SCOPE_AGENT);
        }
    }
    __device__ __forceinline__ void exchange_wait(const Unit& u, int wid, int lane, int which, float scale) const {
        LAS float* S = (LAS float*)(xl + 4096);
        const int row = wid * 32 + (lane & 31);
        unsigned long long* slots = (unsigned long long*)xb + ((size_t)u.pm * BM + row) * 8;
        float t = 0.f; bool done = lane >= 32;
        for (unsigned it = 0; it < (1u << 15); ++it) {
            if (!done) {
                bool ok = true; float acc = 0.f;
#pragma unroll
                for (int h4 = 0; h4 < 2; ++h4) {
                    unsigned long long w[4];
#pragma unroll
                    for (int k = 0; k < 4; ++k) w[k] = __hip_atomic_load(slots + 4 * h4 + k, __ATOMIC_RELAXED, __HIP_MEMORY_SCOPE_AGENT);
#pragma unroll
                    for (int k = 0; k < 4; ++k) { ok = ok && ((unsigned)(w[k] >> 32) == want); acc += __uint_as_float((unsigned)w[k]); }
                    asm volatile("" ::: "memory");
                }
                if (ok) { t = acc; done = true; }
            }
            if (!__any(!done)) break;
            __builtin_amdgcn_s_sleep(1);
        }
        if (lane < 32) S[row] = scale * rsqrtf(t * (1.0f / DM) + EPS);
        asm volatile("s_waitcnt vmcnt(0) lgkmcnt(0)" ::: "memory"); __builtin_amdgcn_s_barrier(); asm volatile("" ::: "memory");
    }
    __device__ __forceinline__ void publish(const f32x4 (&v)[2][2][4][2], const Unit& u, int wr, int wc, int fr, int fq, int wid, int lane) const {
        LAS float* P = (LAS float*)xl;
#pragma unroll
        for (int ai = 0; ai < 2; ++ai)
#pragma unroll
            for (int m = 0; m < 4; ++m) {
                float q = 0.f;
#pragma unroll
                for (int bj = 0; bj < 2; ++bj)
#pragma unroll
                    for (int n = 0; n < 2; ++n) { const f32x4 x = v[ai][bj][m][n]; q += (x[0] * x[0] + x[1] * x[1]) + (x[2] * x[2] + x[3] * x[3]); }
                q += __shfl_xor(q, 16); q += __shfl_xor(q, 32);
                if (fq == 0) P[(ai * HALF + wr * 64 + m * 16 + fr) * 4 + wc] = q;
            }
        asm volatile("s_waitcnt lgkmcnt(0)" ::: "memory"); __builtin_amdgcn_s_barrier(); asm volatile("" ::: "memory");
        const int row = wid * 32 + (lane & 31);
        if (lane < 32) ((GAS float*)rs)[((size_t)u.pm * BM + row) * 8 + u.pn] = (P[row * 4 + 0] + P[row * 4 + 1]) + (P[row * 4 + 2] + P[row * 4 + 3]);
    }
    __device__ __forceinline__ void operator()(f32x4 (&acc)[2][2][4][2], const Unit& u, int wr, int wc, int fr_in, int fq_in) const {
        int fr = fr_in, fq = fq_in; asm volatile("" : "+v"(fr), "+v"(fq));
        const int wid = wr * 4 + wc, lane = fq * 16 + fr;
        const LAS float* S = (const LAS float*)(xl + 4096);
        const int col0 = u.pn * BM + wc * 32 + 8 * fq;
        exchange_post(acc, u, wr, wc, fr, fq, wid, lane, 0);
        u32x4 xv[2][4][2];
#pragma unroll
        for (int ai = 0; ai < 2; ++ai)
#pragma unroll
            for (int m = 0; m < 3; ++m)
#pragma unroll
                for (int bj = 0; bj < 2; ++bj)
                    xv[ai][m][bj] = *(const GAS u32x4*)((const GAS bf16_t*)XB + ((size_t)u.pm * BM + ai * HALF + wr * 64 + m * 16 + fr) * DM + col0 + bj * HALF);
        exchange_wait(u, wid, lane, 0, wgt);
#pragma unroll
        for (int ai = 0; ai < 2; ++ai)
#pragma unroll
            for (int bj = 0; bj < 2; ++bj)
                xv[ai][3][bj] = *(const GAS u32x4*)((const GAS bf16_t*)XB + ((size_t)u.pm * BM + ai * HALF + wr * 64 + 3 * 16 + fr) * DM + col0 + bj * HALF);
        f32x4 gp[2][2];
#pragma unroll
        for (int bj = 0; bj < 2; ++bj)
#pragma unroll
            for (int n = 0; n < 2; ++n) gp[bj][n] = *(const GAS f32x4*)((const GAS float*)g_post + col0 + bj * HALF + 4 * n);
#pragma unroll
        for (int ai = 0; ai < 2; ++ai)
#pragma unroll
            for (int m = 0; m < 4; ++m) {
                const int r = ai * HALF + wr * 64 + m * 16 + fr; const float sr = S[r];
                const size_t off = ((size_t)u.pm * BM + r) * DM + col0;
#pragma unroll
                for (int bj = 0; bj < 2; ++bj) {
                    const u32x4 xw = xv[ai][m][bj];
                    const f32x4 x0 = (f32x4){bflo(xw.x), bfhi(xw.x), bflo(xw.y), bfhi(xw.y)}, x1 = (f32x4){bflo(xw.z), bfhi(xw.z), bflo(xw.w), bfhi(xw.w)};
                    const f32x4 o0 = x0 + acc[ai][bj][m][0] * gp[bj][0] * sr, o1 = x1 + acc[ai][bj][m][1] * gp[bj][1] * sr;
                    acc[ai][bj][m][0] = o0; acc[ai][bj][m][1] = o1;
                    if (OUT) { *(GAS f32x4*)((GAS float*)OUT + off + bj * HALF) = o0; *(GAS f32x4*)((GAS float*)OUT + off + bj * HALF + 4) = o1; }
                    else { u32x4 w; w.x = cvt_pk_bf16(o0[0], o0[1]); w.y = cvt_pk_bf16(o0[2], o0[3]); w.z = cvt_pk_bf16(o1[0], o1[1]); w.w = cvt_pk_bf16(o1[2], o1[3]);
                           *(GAS u32x4*)((GAS bf16_t*)XB + off + bj * HALF) = w; }
                }
            }
        if (!OUT) publish(acc, u, wr, wc, fr, fq, wid, lane);
    }
};

template <class Epi, class Sched, bool HALFN = false>
__device__ __forceinline__ void gemm_phase(LAS unsigned char* lds, const Gemm g, const Sched& S, const Epi& E) {
    const int tid = fresh_tid(), wid = __builtin_amdgcn_readfirstlane(tid >> 6), lane = tid & 63, wr = wid >> 2, wc = wid & 3, fr = lane & 15, fq = lane >> 4;
    const int nt = g.K / BK;
    unsigned voffA[2], voffB[2];
#pragma unroll
    for (int i = 0; i < 2; ++i) { int R, C; stage_rc(tid * 16 + i * 8192, R, C); const int Rb = (R & ~31) + perm32(R & 31);
        voffA[i] = (unsigned)(R * g.lda + C) * 2u; voffB[i] = (unsigned)(Rb * g.ldb + C) * 2u; }
    const size_t kstep = (size_t)(BK * 2);
    const size_t hA = (size_t)HALF * g.lda * 2, hB = (size_t)HALF * g.ldb * 2, tA = 2 * hA, tB = HALFN ? hB : 2 * hB;
    const unsigned ldsw = (unsigned)wid * 1024u;
    const int aoff = lds_byte(wr * 64 + fr, fq * 8), boff = lds_byte(wc * 32 + fr, fq * 8);
#define PG8_SA(b, h) (((b) * 2 + (h)) * HTB)
#define PG8_SB(b, h) ((4 + (b) * 2 + (h)) * HTB)
#define PG8_STAGE(bufoff, gbase, voff) do { _Pragma("unroll") for (int _i = 0; _i < 2; ++_i) \
        __builtin_amdgcn_global_load_lds((const GAS unsigned*)((const GAS char*)(gbase) + (voff)[_i]), (LAS unsigned*)(lds + (bufoff) + ldsw + _i * 8192), 16, 0, 0); } while (0)
#define PG8_LDA(dst, b, h) do { _Pragma("unroll") for (int m = 0; m < 4; ++m) _Pragma("unroll") for (int k = 0; k < 2; ++k) dst[m][k] = *(const LAS bf16x8*)(lds + PG8_SA(b, h) + aoff + m * 2048 + k * 1024); } while (0)
#define PG8_LDB(dst, b, h) do { _Pragma("unroll") for (int n = 0; n < 2; ++n) _Pragma("unroll") for (int k = 0; k < 2; ++k) dst[n][k] = *(const LAS bf16x8*)(lds + PG8_SB(b, h) + boff + n * 2048 + k * 1024); } while (0)
#define PG8_MMA(ai, bj, At, Bt) do { __builtin_amdgcn_s_setprio(1); _Pragma("unroll") for (int m = 0; m < 4; ++m) _Pragma("unroll") for (int n = 0; n < 2; ++n) _Pragma("unroll") for (int k = 0; k < 2; ++k) \
        acc[ai][bj][m][n] = __builtin_amdgcn_mfma_f32_16x16x32_bf16(Bt[n][k], At[m][k], acc[ai][bj][m][n], 0, 0, 0); __builtin_amdgcn_s_setprio(0); } while (0)
#define PG8_WAIT_V(n) asm volatile("s_waitcnt vmcnt(" #n ")" ::: "memory")
#define PG8_WAIT_L(n) asm volatile("s_waitcnt lgkmcnt(" #n ")" ::: "memory")
#define PG8_BAR __builtin_amdgcn_s_barrier()
#define PG8_SCHED __builtin_amdgcn_sched_barrier(0)
    Unit cur, nxt; int ui = 0;
    if (!S.next(0, cur)) return;
    cur.ord = 0;
    f32x4 acc[2][2][4][2];
#pragma unroll
    for (int a = 0; a < 2; ++a)
#pragma unroll
        for (int b = 0; b < 2; ++b)
#pragma unroll
            for (int m = 0; m < 4; ++m)
#pragma unroll
                for (int n = 0; n < 2; ++n) acc[a][b][m][n] = (f32x4){0.f, 0.f, 0.f, 0.f};
    bf16x8 At[4][2], B0[2][2], B1[2][2];
    const GAS char* cA = (const GAS char*)g.A + (size_t)cur.pm * tA + (size_t)(cur.pn >> g.a_shift) * g.a_stride;
    const GAS char* cB = (const GAS char*)g.Bt + (size_t)cur.pn * tB;
    PG8_STAGE(PG8_SB(0, 0), cB, voffB); PG8_STAGE(PG8_SB(0, 1), cB + hB, voffB); PG8_STAGE(PG8_SA(0, 0), cA, voffA); PG8_STAGE(PG8_SA(0, 1), cA + hA, voffA);
    if (wr == 1) PG8_BAR;
    PG8_WAIT_V(2); PG8_BAR;
    PG8_STAGE(PG8_SB(1, 0), cB + kstep, voffB); PG8_STAGE(PG8_SA(1, 0), cA + kstep, voffA); PG8_STAGE(PG8_SB(1, 1), cB + hB + kstep, voffB);
    PG8_WAIT_V(6); PG8_BAR;
    for (;;) {
        const bool has_next = S.next(ui + 1, nxt); nxt.ord = ui + 1;
        const GAS char* nA = has_next ? (const GAS char*)g.A + (size_t)nxt.pm * tA + (size_t)(nxt.pn >> g.a_shift) * g.a_stride : cA;
        const GAS char* nB = has_next ? (const GAS char*)g.Bt + (size_t)nxt.pn * tB : cB;
        for (int t = 0; t < nt; t += 2) {
            const bool last = (t == nt - 2);
            const GAS char* a1 = cA + (size_t)(t + 1) * kstep;
            const GAS char* a2 = last ? nA : cA + (size_t)(t + 2) * kstep; const GAS char* b2 = last ? nB : cB + (size_t)(t + 2) * kstep;
            const GAS char* a3 = a2 + kstep; const GAS char* b3 = b2 + kstep;
            PG8_LDB(B0, 0, 0); if constexpr (!HALFN) PG8_LDB(B1, 0, 1); PG8_SCHED; PG8_LDA(At, 0, 0); PG8_STAGE(PG8_SA(1, 1), a1 + hA, voffA);
            PG8_WAIT_V(8); PG8_WAIT_L(0); PG8_BAR; PG8_MMA(0, 0, At, B0); if constexpr (!HALFN) PG8_MMA(0, 1, At, B1); PG8_BAR; PG8_SCHED;
            PG8_LDA(At, 0, 1); PG8_STAGE(PG8_SB(0, 0), b2, voffB); PG8_STAGE(PG8_SB(0, 1), b2 + hB, voffB); PG8_STAGE(PG8_SA(0, 0), a2, voffA);
            PG8_WAIT_V(8); PG8_WAIT_L(0); PG8_BAR; PG8_MMA(1, 0, At, B0); if constexpr (!HALFN) PG8_MMA(1, 1, At, B1); PG8_BAR; PG8_SCHED;
            PG8_LDB(B0, 1, 0); if constexpr (!HALFN) PG8_LDB(B1, 1, 1); PG8_SCHED; PG8_LDA(At, 1, 0); PG8_STAGE(PG8_SA(0, 1), a2 + hA, voffA);
            PG8_WAIT_V(8); PG8_WAIT_L(0); PG8_BAR; PG8_MMA(0, 0, At, B0); if constexpr (!HALFN) PG8_MMA(0, 1, At, B1); PG8_BAR; PG8_SCHED;
            PG8_LDA(At, 1, 1); PG8_STAGE(PG8_SB(1, 0), b3, voffB); PG8_STAGE(PG8_SB(1, 1), b3 + hB, voffB); PG8_STAGE(PG8_SA(1, 0), a3, voffA);
            PG8_WAIT_V(8); PG8_WAIT_L(0); PG8_BAR; PG8_MMA(1, 0, At, B0); if constexpr (!HALFN) PG8_MMA(1, 1, At, B1); PG8_BAR; PG8_SCHED;
        }
        if (wr == 0) PG8_BAR;
        E(acc, cur, wr, wc, fr, fq);
        if (!has_next) break;
#pragma unroll
        for (int a = 0; a < 2; ++a)
#pragma unroll
            for (int b = 0; b < 2; ++b)
#pragma unroll
                for (int m = 0; m < 4; ++m)
#pragma unroll
                    for (int n = 0; n < 2; ++n) acc[a][b][m][n] = (f32x4){0.f, 0.f, 0.f, 0.f};
        cur = nxt; cA = nA; cB = nB; ++ui;
        if (wr == 1) PG8_BAR;
    }
    PG8_WAIT_V(0);
    PG8_BAR;
#undef PG8_SA
#undef PG8_SB
#undef PG8_STAGE
#undef PG8_LDA
#undef PG8_LDB
#undef PG8_MMA
#undef PG8_WAIT_V
#undef PG8_WAIT_L
#undef PG8_BAR
#undef PG8_SCHED
}
}

__device__ __forceinline__ void norm_pass(const float* xin, float* xout, const float* y, const float* part, float wgt, const float* g_post, const float* g_pre, bf16_t* h,
                                          int nrows, int gw, int ngw, int lane) {
    for (int row = gw; row < nrows; row += ngw) {
        const GAS f32x4* xr = (const GAS f32x4*)(xin + (size_t)row * DM) + lane;
        f32x4 v[8];
#pragma unroll
        for (int j = 0; j < 8; ++j) v[j] = xr[64 * j];
        if (y) {
            const float ps = (lane < 32) ? ((const GAS float*)part)[(size_t)lane * MTOK + row] : 0.f;
            const float ss = wave_sum(ps);
            const float r = wgt * rsqrtf(ss * (1.0f / DM) + EPS);
            const GAS f32x4* yr = (const GAS f32x4*)(y + (size_t)row * DM) + lane; const GAS f32x4* gp = (const GAS f32x4*)g_post + lane;
#pragma unroll
            for (int j = 0; j < 8; ++j) v[j] += yr[64 * j] * gp[64 * j] * r;
        }
        if (xout) { GAS f32x4* xo = (GAS f32x4*)(xout + (size_t)row * DM) + lane;
#pragma unroll
            for (int j = 0; j < 8; ++j) xo[64 * j] = v[j]; }
        if (h) {
            float s2 = 0.f;
#pragma unroll
            for (int j = 0; j < 8; ++j) s2 += (v[j][0] * v[j][0] + v[j][1] * v[j][1]) + (v[j][2] * v[j][2] + v[j][3] * v[j][3]);
            s2 = wave_sum(s2);
            const float r2 = rsqrtf(s2 * (1.0f / DM) + EPS);
            const GAS f32x4* gq = (const GAS f32x4*)g_pre + lane; GAS u32x2* ho = (GAS u32x2*)(h + (size_t)row * DM) + lane;
#pragma unroll
            for (int j = 0; j < 8; ++j) { const f32x4 o = v[j] * gq[64 * j] * r2; u32x2 w; w.x = cvt_pk_bf16(o[0], o[1]); w.y = cvt_pk_bf16(o[2], o[3]); ho[64 * j] = w; }
        }
    }
}

__device__ __forceinline__ void prep_pass(const float* xin, bf16_t* xb, float* rs, int nrows, int gw, int ngw, int lane) {
    for (int row = gw; row < nrows; row += ngw) {
        const GAS f32x4* xr = (const GAS f32x4*)(xin + (size_t)row * DM) + lane;
        f32x4 v[8];
#pragma unroll
        for (int j = 0; j < 8; ++j) v[j] = xr[64 * j];
        float s2 = 0.f;
#pragma unroll
        for (int j = 0; j < 8; ++j) s2 += (v[j][0] * v[j][0] + v[j][1] * v[j][1]) + (v[j][2] * v[j][2] + v[j][3] * v[j][3]);
        s2 = wave_sum(s2);
        GAS u32x2* ho = (GAS u32x2*)(xb + (size_t)row * DM) + lane;
#pragma unroll
        for (int j = 0; j < 8; ++j) { u32x2 w; w.x = cvt_pk_bf16(v[j][0], v[j][1]); w.y = cvt_pk_bf16(v[j][2], v[j][3]); ho[64 * j] = w; }
        if (lane < 8) ((GAS float*)rs)[(size_t)row * 8 + lane] = (lane == 0) ? s2 : 0.f;
    }
}

__device__ __forceinline__ void rope_rot(const u32x4 x1, const u32x4 x2, const f32x2* tb, u32x4& r1, u32x4& r2) {
    const GAS f32x4* t = (const GAS f32x4*)tb;
#pragma unroll
    for (int p = 0; p < 4; ++p) {
        const f32x4 cc = t[p]; const f32x2 c0 = {cc[0], cc[1]}, c1 = {cc[2], cc[3]};
        const float a0 = bflo(x1[p]), a1 = bfhi(x1[p]), b0 = bflo(x2[p]), b1 = bfhi(x2[p]);
        r1[p] = cvt_pk_bf16(a0 * c0.x - b0 * c0.y, a1 * c1.x - b1 * c1.y);
        r2[p] = cvt_pk_bf16(b0 * c0.x + a0 * c0.y, b1 * c1.x + a1 * c1.y);
    }
}

__device__ __forceinline__ void rope_rot_t(const u32x4 x1, const u32x4 x2, const f32x4 (&cc)[4], u32x4& r1, u32x4& r2) {
#pragma unroll
    for (int p = 0; p < 4; ++p) {
        const f32x2 c0 = {cc[p][0], cc[p][1]}, c1 = {cc[p][2], cc[p][3]};
        const float a0 = bflo(x1[p]), a1 = bfhi(x1[p]), b0 = bflo(x2[p]), b1 = bfhi(x2[p]);
        r1[p] = cvt_pk_bf16(a0 * c0.x - b0 * c0.y, a1 * c1.x - b1 * c1.y);
        r2[p] = cvt_pk_bf16(b0 * c0.x + a0 * c0.y, b1 * c1.x + a1 * c1.y);
    }
}
constexpr int SA_KLD = 72, SA_VLD = 280;
__device__ __forceinline__ void attn_unit(LAS unsigned char* lds, const bf16_t* z, bf16_t* cat, const f32x2* rope, const float* sinks, int unit, int tid, int wid, int lane) {
    const int kvh = unit & 1, blk = (unit >> 1) & 31, b = unit >> 6;
    const int tokq = b * SEQ + blk * 128, tokk = tokq - 128;
    LAS bf16_t* Ks = (LAS bf16_t*)lds;
    LAS bf16_t* Vt = (LAS bf16_t*)(lds + 256 * SA_KLD * 2);
    const GAS bf16_t* zg = (const GAS bf16_t*)z;
    {
        u32x4 kva[4], vva[4], x1a[4], x2a[4]; f32x4 tba[4][4];
#pragma unroll
        for (int c = 0; c < 4; ++c) {
            const int idx = tid + 512 * c, key = idx >> 3, ch = idx & 7;
            const int pos = blk * 128 - 128 + key; const bool okp = pos >= 0;
            const GAS bf16_t* zr = zg + (size_t)(okp ? tokk + key : tokq) * INW;
            kva[c] = *(const GAS u32x4*)(zr + 1024 + kvh * 64 + ch * 8);
            vva[c] = *(const GAS u32x4*)(zr + 1152 + kvh * 64 + ch * 8);
            x1a[c] = *(const GAS u32x4*)(zr + 1024 + kvh * 64); x2a[c] = *(const GAS u32x4*)(zr + 1024 + kvh * 64 + 8);
            const GAS f32x4* tp = (const GAS f32x4*)(rope + (size_t)(okp ? pos : 0) * 8);
#pragma unroll
            for (int p = 0; p < 4; ++p) tba[c][p] = tp[p];
        }
        asm volatile("" ::: "memory");
#pragma unroll
        for (int c = 0; c < 4; ++c) {
            const int idx = tid + 512 * c, key = idx >> 3, ch = idx & 7;
            const bool okp = (blk * 128 - 128 + key) >= 0;
            u32x4 r1, r2; rope_rot_t(x1a[c], x2a[c], tba[c], r1, r2);
            u32x4 kv = ch == 0 ? r1 : (ch == 1 ? r2 : kva[c]), vv = vva[c];
            if (!okp) { kv = (u32x4){0u, 0u, 0u, 0u}; vv = (u32x4){0u, 0u, 0u, 0u}; }
            *(LAS u32x4*)(Ks + key * SA_KLD + ch * 8) = kv;
#pragma unroll
            for (int p = 0; p < 4; ++p) { Vt[(ch * 8 + 2 * p) * SA_VLD + key] = (bf16_t)(vv[p] & 0xffffu); Vt[(ch * 8 + 2 * p + 1) * SA_VLD + key] = (bf16_t)(vv[p] >> 16); }
        }
    }
    for (int idx = tid; idx < 64 * 24; idx += 512) Vt[(idx / 24) * SA_VLD + 256 + (idx % 24)] = 0;
    __syncthreads();
    const int hq = kvh * 8 + wid; const float sink = ((const GAS float*)sinks)[hq];
    const int qi = lane & 15, g = lane >> 4;
    for (int qs = 0; qs < 8; ++qs) {
        const int row = tokq + 16 * qs + qi, pos = blk * 128 + 16 * qs + qi;
        const GAS bf16_t* zr = zg + (size_t)row * INW + hq * 64;
        bf16x8 qf0, qf1;
        { const u32x4 x1 = *(const GAS u32x4*)(zr), x2 = *(const GAS u32x4*)(zr + 8); u32x4 r1, r2; rope_rot(x1, x2, rope + (size_t)pos * 8, r1, r2);
          const u32x4 own = *(const GAS u32x4*)(zr + 8 * g);
          const u32x4 sel = g == 0 ? r1 : (g == 1 ? r2 : own); qf0 = __builtin_bit_cast(bf16x8, sel); }
        qf1 = __builtin_bit_cast(bf16x8, *(const GAS u32x4*)(zr + 32 + 8 * g));
        f32x4 s[9];
#pragma unroll
        for (int t3 = 0; t3 < 3; ++t3) {
            bf16x8 ka[3], kb[3];
#pragma unroll
            for (int i = 0; i < 3; ++i) { const LAS bf16_t* kp = Ks + (16 * (qs + 3 * t3 + i) + qi) * SA_KLD + 8 * g; ka[i] = *(const LAS bf16x8*)kp; kb[i] = *(const LAS bf16x8*)(kp + 32); }
            f32x4 acc[3];
#pragma unroll
            for (int i = 0; i < 3; ++i) acc[i] = MFMA16(ka[i], qf0, ((f32x4){0.f, 0.f, 0.f, 0.f}));
#pragma unroll
            for (int i = 0; i < 3; ++i) s[3 * t3 + i] = MFMA16(kb[i], qf1, acc[i]);
            __builtin_amdgcn_sched_barrier(0);
        }
        float mx = sink;
        const int i = 16 * qs + qi;
#pragma unroll
        for (int t = 0; t < 9; ++t)
#pragma unroll
            for (int r = 0; r < 4; ++r) {
                const int j = 16 * (qs + t) + 4 * g + r;
                const bool valid = (j > i) && (j <= i + 128) && (blk > 0 || j >= 128);
                const float v = valid ? s[t][r] * 0.125f : -1e30f; s[t][r] = v; mx = fmaxf(mx, v);
            }
        mx = fmaxf(mx, __shfl_xor(mx, 16)); mx = fmaxf(mx, __shfl_xor(mx, 32));
        float l = 0.f;
#pragma unroll
        for (int t = 0; t < 9; ++t)
#pragma unroll
            for (int r = 0; r < 4; ++r) { const float e = __expf(s[t][r] - mx); s[t][r] = e; l += e; }
        l += __shfl_xor(l, 16); l += __shfl_xor(l, 32); l += __expf(sink - mx);
        const float inv = 1.0f / l;
        bf16x8 pf[5];
#pragma unroll
        for (int s5 = 0; s5 < 5; ++s5) {
            u32x4 w; w.x = cvt_pk_bf16(s[2 * s5][0], s[2 * s5][1]); w.y = cvt_pk_bf16(s[2 * s5][2], s[2 * s5][3]);
            if (2 * s5 + 1 < 9) { w.z = cvt_pk_bf16(s[(2 * s5 + 1) % 9][0], s[(2 * s5 + 1) % 9][1]); w.w = cvt_pk_bf16(s[(2 * s5 + 1) % 9][2], s[(2 * s5 + 1) % 9][3]); } else { w.z = 0u; w.w = 0u; }
            pf[s5] = __builtin_bit_cast(bf16x8, w);
        }
        f32x4 ov[4];
#pragma unroll
        for (int dt = 0; dt < 4; ++dt) ov[dt] = (f32x4){0.f, 0.f, 0.f, 0.f};
#pragma unroll
        for (int s5 = 0; s5 < 5; ++s5) {
            bf16x8 vf[4];
#pragma unroll
            for (int dt = 0; dt < 4; ++dt) {
                const LAS bf16_t* vp = Vt + (16 * dt + qi) * SA_VLD + 16 * (qs + 2 * s5) + 4 * g;
                const s16x4 lo = *(const LAS s16x4*)vp, hi = *(const LAS s16x4*)(vp + 16);
                vf[dt] = __builtin_shufflevector(lo, hi, 0, 1, 2, 3, 4, 5, 6, 7);
            }
#pragma unroll
            for (int dt = 0; dt < 4; ++dt) ov[dt] = MFMA16(vf[dt], pf[s5], ov[dt]);
            __builtin_amdgcn_sched_barrier(0);
        }
#pragma unroll
        for (int dt = 0; dt < 4; ++dt) {
            u32x2 w; w.x = cvt_pk_bf16(ov[dt][0] * inv, ov[dt][1] * inv); w.y = cvt_pk_bf16(ov[dt][2] * inv, ov[dt][3] * inv);
            *(GAS u32x2*)((GAS bf16_t*)cat + (size_t)row * DM + hq * 64 + 16 * dt + 4 * g) = w;
        }
    }
    __syncthreads();
}

constexpr int SG_LD = 136;
__device__ __forceinline__ void sgu_unit(LAS unsigned char* lds, const bf16_t* z, bf16_t* cat, const f32x2* sst, const bf16_t* wsgu, const float* ln_g, const float* ln_b, const float* b_s,
                                         int unit, int tid, int wid, int lane) {
    const int grp = unit & 7, chunk = (unit >> 3) & 31, b = unit >> 8;
    const int tb = b * SEQ + chunk * 128;
    LAS bf16_t* Vt = (LAS bf16_t*)lds;
    LAS bf16_t* Wl = (LAS bf16_t*)(lds + 128 * SG_LD * 2);
    LAS float* mu = (LAS float*)(lds + 2 * 128 * SG_LD * 2); LAS float* rs = mu + 128;
    const GAS bf16_t* zg = (const GAS bf16_t*)z;
    if (tid < 128) {
        float s1 = 0.f, s2 = 0.f;
#pragma unroll
        for (int p = 0; p < 16; ++p) { const f32x2 v = ((const GAS f32x2*)sst)[(size_t)p * MTOK + tb + tid]; s1 += v.x; s2 += v.y; }
        const float m = s1 * (1.0f / 1024.0f); const float var = fmaxf(s2 * (1.0f / 1024.0f) - m * m, 0.f);
        mu[tid] = m; rs[tid] = rsqrtf(var + EPS);
    }
    __syncthreads();
    {
        const int ch = tid & 15;
        u32x4 vva[4], wwa[4];
#pragma unroll
        for (int c = 0; c < 4; ++c) {
            const int idx = tid + 512 * c, j = idx >> 4;
            vva[c] = *(const GAS u32x4*)(zg + (size_t)(tb + j) * INW + 2304 + grp * 128 + ch * 8);
            wwa[c] = *(const GAS u32x4*)((const GAS bf16_t*)wsgu + (size_t)grp * 16384 + j * 128 + ch * 8);
        }
        const GAS float* lg = (const GAS float*)ln_g + grp * 128 + ch * 8; const GAS float* lb = (const GAS float*)ln_b + grp * 128 + ch * 8;
        const f32x4 lg0 = *(const GAS f32x4*)lg, lg1 = *(const GAS f32x4*)(lg + 4), lb0 = *(const GAS f32x4*)lb, lb1 = *(const GAS f32x4*)(lb + 4);
        const float lgv[8] = {lg0[0], lg0[1], lg0[2], lg0[3], lg1[0], lg1[1], lg1[2], lg1[3]}, lbv[8] = {lb0[0], lb0[1], lb0[2], lb0[3], lb1[0], lb1[1], lb1[2], lb1[3]};
        asm volatile("" ::: "memory");
#pragma unroll
        for (int c = 0; c < 4; ++c) {
            const int idx = tid + 512 * c, j = idx >> 4;
            const float m = mu[j], r = rs[j];
#pragma unroll
            for (int p = 0; p < 4; ++p) {
                const float v0 = (bflo(vva[c][p]) - m) * r * lgv[2 * p] + lbv[2 * p], v1 = (bfhi(vva[c][p]) - m) * r * lgv[2 * p + 1] + lbv[2 * p + 1];
                const unsigned w = cvt_pk_bf16(v0, v1);
                Vt[(ch * 8 + 2 * p) * SG_LD + j] = (bf16_t)(w & 0xffffu); Vt[(ch * 8 + 2 * p + 1) * SG_LD + j] = (bf16_t)(w >> 16);
            }
            *(LAS u32x4*)(Wl + j * SG_LD + ch * 8) = wwa[c];
        }
    }
    __syncthreads();
    const int li = lane & 15, g = lane >> 4;
    u32x2 uuv[8]; float biasv[8];
#pragma unroll
    for (int it = 0; it < 8; ++it) {
        uuv[it] = *(const GAS u32x2*)(zg + (size_t)(tb + 16 * it + li) * INW + 1280 + grp * 128 + 16 * wid + 4 * g);
        biasv[it] = ((const GAS float*)b_s)[grp * 128 + 16 * it + li];
    }
    bf16x8 af[4];
#pragma unroll
    for (int ks = 0; ks < 4; ++ks) af[ks] = *(const LAS bf16x8*)(Vt + (16 * wid + li) * SG_LD + 32 * ks + 8 * g);
#pragma unroll
    for (int ip = 0; ip < 4; ++ip) {
        bf16x8 b0[4], b1[4];
#pragma unroll
        for (int ks = 0; ks < 4; ++ks) if (ks <= ip) {
            b0[ks] = *(const LAS bf16x8*)(Wl + (16 * (2 * ip) + li) * SG_LD + 32 * ks + 8 * g);
            b1[ks] = *(const LAS bf16x8*)(Wl + (16 * (2 * ip + 1) + li) * SG_LD + 32 * ks + 8 * g);
        }
        f32x4 acc2[2] = {(f32x4){0.f, 0.f, 0.f, 0.f}, (f32x4){0.f, 0.f, 0.f, 0.f}};
#pragma unroll
        for (int ks = 0; ks < 4; ++ks) if (ks <= ip) { acc2[0] = MFMA16(af[ks], b0[ks], acc2[0]); acc2[1] = MFMA16(af[ks], b1[ks], acc2[1]); }
#pragma unroll
        for (int h = 0; h < 2; ++h) {
            const int it = 2 * ip + h; const f32x4 acc = acc2[h];
            const int tok = tb + 16 * it + li; const int c0 = grp * 128 + 16 * wid + 4 * g;
            const float bias = biasv[it];
            const u32x2 uu = uuv[it];
            u32x2 w; w.x = cvt_pk_bf16(bflo(uu.x) * (acc[0] + bias), bfhi(uu.x) * (acc[1] + bias)); w.y = cvt_pk_bf16(bflo(uu.y) * (acc[2] + bias), bfhi(uu.y) * (acc[3] + bias));
            *(GAS u32x2*)((GAS bf16_t*)cat + (size_t)tok * DM + 1024 + c0) = w;
        }
    }
    __syncthreads();
}

constexpr int XA_KLD = 136, XA_VLD = 264;
__device__ __forceinline__ void xattn_unit(LAS unsigned char* lds, const bf16_t* q, const bf16_t* kv, bf16_t* o, int unit, int tid, int wid, int lane) {
    const int qb = unit & 15, head = (unit >> 4) & 3, b = unit >> 6;
    LAS bf16_t* Kc = (LAS bf16_t*)lds;
    LAS bf16_t* Vt = (LAS bf16_t*)(lds + 256 * XA_KLD * 2);
    const GAS bf16_t* kvg = (const GAS bf16_t*)kv;
    {
        u32x4 kka[8], vva[8];
#pragma unroll
        for (int c = 0; c < 8; ++c) {
            const int idx = tid + 512 * c, key = idx >> 4, ch = idx & 15;
            const GAS bf16_t* kr = kvg + (size_t)(b * 256 + key) * 1024 + head * 128 + ch * 8;
            kka[c] = *(const GAS u32x4*)kr; vva[c] = *(const GAS u32x4*)(kr + 512);
        }
        asm volatile("" ::: "memory");
#pragma unroll
        for (int c = 0; c < 8; ++c) {
            const int idx = tid + 512 * c, key = idx >> 4, ch = idx & 15;
            *(LAS u32x4*)(Kc + key * XA_KLD + ch * 8) = kka[c];
#pragma unroll
            for (int p = 0; p < 4; ++p) { Vt[(ch * 8 + 2 * p) * XA_VLD + key] = (bf16_t)(vva[c][p] & 0xffffu); Vt[(ch * 8 + 2 * p + 1) * XA_VLD + key] = (bf16_t)(vva[c][p] >> 16); }
        }
    }
    __syncthreads();
    const int qi = lane & 15, g = lane >> 4;
    for (int sb = 0; sb < 2; ++sb) {
        const int row = b * SEQ + qb * 256 + wid * 32 + sb * 16 + qi;
        const GAS bf16_t* qr = (const GAS bf16_t*)q + (size_t)row * 512 + head * 128 + 8 * g;
        bf16x8 qf[4];
#pragma unroll
        for (int ks = 0; ks < 4; ++ks) qf[ks] = __builtin_bit_cast(bf16x8, *(const GAS u32x4*)(qr + 32 * ks));
        f32x4 s[16];
#pragma unroll
        for (int k4 = 0; k4 < 4; ++k4) {
            bf16x8 kf[4][4];
#pragma unroll
            for (int i = 0; i < 4; ++i)
#pragma unroll
                for (int ks = 0; ks < 4; ++ks) kf[i][ks] = *(const LAS bf16x8*)(Kc + (16 * (4 * k4 + i) + qi) * XA_KLD + 32 * ks + 8 * g);
            f32x4 acc[4];
#pragma unroll
            for (int i = 0; i < 4; ++i) acc[i] = (f32x4){0.f, 0.f, 0.f, 0.f};
#pragma unroll
            for (int ks = 0; ks < 4; ++ks)
#pragma unroll
                for (int i = 0; i < 4; ++i) acc[i] = MFMA16(kf[i][ks], qf[ks], acc[i]);
#pragma unroll
            for (int i = 0; i < 4; ++i) s[4 * k4 + i] = acc[i] * 0.08838834764831845f;
            __builtin_amdgcn_sched_barrier(0);
        }
        float mx = -1e30f;
#pragma unroll
        for (int kt = 0; kt < 16; ++kt) mx = fmaxf(fmaxf(mx, fmaxf(s[kt][0], s[kt][1])), fmaxf(s[kt][2], s[kt][3]));
        mx = fmaxf(mx, __shfl_xor(mx, 16)); mx = fmaxf(mx, __shfl_xor(mx, 32));
        float l = 0.f;
#pragma unroll
        for (int kt = 0; kt < 16; ++kt)
#pragma unroll
            for (int r = 0; r < 4; ++r) { const float e = __expf(s[kt][r] - mx); s[kt][r] = e; l += e; }
        l += __shfl_xor(l, 16); l += __shfl_xor(l, 32);
        const float inv = 1.0f / l;
        bf16x8 pf[8];
#pragma unroll
        for (int s8 = 0; s8 < 8; ++s8) {
            u32x4 w; w.x = cvt_pk_bf16(s[2 * s8][0], s[2 * s8][1]); w.y = cvt_pk_bf16(s[2 * s8][2], s[2 * s8][3]);
            w.z = cvt_pk_bf16(s[2 * s8 + 1][0], s[2 * s8 + 1][1]); w.w = cvt_pk_bf16(s[2 * s8 + 1][2], s[2 * s8 + 1][3]);
            pf[s8] = __builtin_bit_cast(bf16x8, w);
        }
        f32x4 ov[8];
#pragma unroll
        for (int dt = 0; dt < 8; ++dt) ov[dt] = (f32x4){0.f, 0.f, 0.f, 0.f};
#pragma unroll
        for (int s8 = 0; s8 < 8; ++s8) {
            bf16x8 vf[8];
#pragma unroll
            for (int dt = 0; dt < 8; ++dt) {
                const LAS bf16_t* vp = Vt + (16 * dt + qi) * XA_VLD + 32 * s8 + 4 * g;
                const s16x4 lo = *(const LAS s16x4*)vp, hi = *(const LAS s16x4*)(vp + 16);
                vf[dt] = __builtin_shufflevector(lo, hi, 0, 1, 2, 3, 4, 5, 6, 7);
            }
#pragma unroll
            for (int dt = 0; dt < 8; ++dt) ov[dt] = MFMA16(vf[dt], pf[s8], ov[dt]);
            __builtin_amdgcn_sched_barrier(0);
        }
#pragma unroll
        for (int dt = 0; dt < 8; ++dt) {
            u32x2 w; w.x = cvt_pk_bf16(ov[dt][0] * inv, ov[dt][1] * inv); w.y = cvt_pk_bf16(ov[dt][2] * inv, ov[dt][3] * inv);
            *(GAS u32x2*)((GAS bf16_t*)o + (size_t)row * 512 + head * 128 + 16 * dt + 4 * g) = w;
        }
    }
    __syncthreads();
}

template <int W>
__device__ __forceinline__ void pool_body(const LAS float* R, const GAS bf16_t* hg, const f32x4 gv, GAS bf16_t* pg, int t0, int s0) {
    constexpr int NR = W - 1 + 32;
    u32x2 v[NR];
#pragma unroll
    for (int k = 0; k < NR; ++k) { const int tok = t0 - (W - 1) + k; v[k] = *(const GAS u32x2*)(hg + (size_t)(tok < 0 ? 0 : tok) * DM); }
    f32x4 sum = (f32x4){0.f, 0.f, 0.f, 0.f};
#pragma unroll
    for (int k = 0; k < W - 1; ++k) { const float r = R[16 - W + k]; sum += (f32x4){bflo(v[k].x), bfhi(v[k].x), bflo(v[k].y), bfhi(v[k].y)} * r; }
#pragma unroll
    for (int i = 0; i < 32; ++i) {
        const float r = R[15 + i];
        const f32x4 cur = (f32x4){bflo(v[W - 1 + i].x), bfhi(v[W - 1 + i].x), bflo(v[W - 1 + i].y), bfhi(v[W - 1 + i].y)} * r;
        const int cnt = (s0 + i + 1) < W ? (s0 + i + 1) : W;
        const float ic = 1.0f / (float)cnt;
        sum += cur;
        const f32x4 o = (sum * ic - cur) * gv;
        u32x2 wv; wv.x = cvt_pk_bf16(o[0], o[1]); wv.y = cvt_pk_bf16(o[2], o[3]);
        *(GAS u32x2*)(pg + (size_t)(t0 + i) * DM) = wv;
        const float ro = R[15 + i - (W - 1)];
        sum -= (f32x4){bflo(v[i].x), bfhi(v[i].x), bflo(v[i].y), bfhi(v[i].y)} * ro;
    }
}
__device__ __forceinline__ void pool_unit(LAS unsigned char* lds, const bf16_t* xb, const float* rs, const float* gpre, bf16_t* pooled, int unit, int tid) {
    LAS float* R = (LAS float*)lds;
    const int t0 = unit * 32, s0 = t0 & (SEQ - 1);
    if (tid < 47) { const int tok = t0 - 15 + tid; R[tid] = ((s0 - 15 + tid) >= 0) ? row_rs(rs, tok) : 0.f; }
    __syncthreads();
    const int c0 = tid * 4;
    const GAS bf16_t* hg = (const GAS bf16_t*)xb + c0; GAS bf16_t* pg = (GAS bf16_t*)pooled + c0;
    const f32x4 gv = *(const GAS f32x4*)((const GAS float*)gpre + c0);
    const int grp = __builtin_amdgcn_readfirstlane(c0 >> 9);
    if (grp == 0) pool_body<2>(R, hg, gv, pg, t0, s0);
    else if (grp == 1) pool_body<4>(R, hg, gv, pg, t0, s0);
    else if (grp == 2) pool_body<8>(R, hg, gv, pg, t0, s0);
    else pool_body<16>(R, hg, gv, pg, t0, s0);
    __syncthreads();
}

#define XB_TMO      128
#define XB_XCNT(j)  (256  + 64 * (j))
#define XB_XSUB(j)  (1280 + 64 * (j))
#define XB_XGEN(j)  (2304 + 64 * (j))
#define XB_TOP      3328
#define XB_TOPGEN   3392
#define XCD_BAR_WORDS 3456
#define XB_SPIN_CAP (1u << 22)
__device__ __forceinline__ unsigned xb_ld(unsigned* p)              { return __hip_atomic_load(p, __ATOMIC_RELAXED, __HIP_MEMORY_SCOPE_AGENT); }
__device__ __forceinline__ unsigned xb_add(unsigned* p, unsigned v) { return __hip_atomic_fetch_add(p, v, __ATOMIC_RELAXED, __HIP_MEMORY_SCOPE_AGENT); }
__device__ __forceinline__ unsigned xb_xcc_id() { return (unsigned)__builtin_amdgcn_s_getreg((3 << 11) | 20) & 0xFu; }
#define XB_SPIN(cond, bar) do { unsigned _sp = 0; while (cond) { __builtin_amdgcn_s_sleep(1); \
    if ((++_sp & 255u) == 0u) { if (xb_ld(&(bar)[XB_TMO])) break; if (_sp > XB_SPIN_CAP) { atomicAdd(&(bar)[XB_TMO], 1u); break; } } } } while (0)
struct XcdBarrier { unsigned* bar; unsigned x; volatile LAS unsigned* st; };
__device__ __forceinline__ XcdBarrier xcd_barrier_post(unsigned* bar, volatile LAS unsigned* st) {
    XcdBarrier b; b.bar = bar; b.x = xb_xcc_id(); b.st = st;
    if (threadIdx.x == 0) (void)xb_add(&bar[XB_XCNT(b.x)], 1u);
    return b;
}
__device__ __forceinline__ void xcd_barrier_complete(unsigned* bar, unsigned x, unsigned& nloc, unsigned& nx) {
    const unsigned G = gridDim.x * gridDim.y * gridDim.z;
    unsigned sum, cnt, mine, sp = 0u;
    for (;;) {
        sum = 0u; cnt = 0u; mine = 0u;
#pragma unroll
        for (unsigned j = 0; j < 16; ++j) { const unsigned c = xb_ld(&bar[XB_XCNT(j)]); sum += c; cnt += (c > 0u) ? 1u : 0u; mine = (j == x) ? c : mine; }
        if (sum == G) break;
        __builtin_amdgcn_s_sleep(1);
        if ((++sp & 255u) == 0u) { if (xb_ld(&bar[XB_TMO])) break; if (sp > XB_SPIN_CAP) { atomicAdd(&bar[XB_TMO], 1u); break; } }
    }
    nloc = mine > 0u ? mine : 1u; nx = cnt > 0u ? cnt : 1u;
}
__device__ __forceinline__ void xcd_barrier(const XcdBarrier& b) {
    asm volatile("s_waitcnt vmcnt(0)" ::: "memory");
    __syncthreads();
    if (threadIdx.x == 0) {
        unsigned* bar = b.bar;
        __builtin_amdgcn_s_waitcnt(0);
        unsigned nloc = b.st[0], nx = b.st[1];
        if (nloc == 0u) { xcd_barrier_complete(bar, b.x, nloc, nx); b.st[0] = nloc; b.st[1] = nx; }
        const unsigned old = xb_add(&bar[XB_XSUB(b.x)], 1u);
        const unsigned gen = old / nloc;
        if (old + 1u == (gen + 1u) * nloc) {
            __builtin_amdgcn_fence(__ATOMIC_RELEASE, "agent");
            asm volatile("s_waitcnt vmcnt(0)" ::: "memory");
            const unsigned og = xb_add(&bar[XB_TOP], 1u);
            const unsigned tg = og / nx;
            if (og + 1u == (tg + 1u) * nx) xb_add(&bar[XB_TOPGEN], 1u);
            else XB_SPIN(xb_ld(&bar[XB_TOPGEN]) == tg, bar);
            __builtin_amdgcn_fence(__ATOMIC_ACQUIRE, "agent");
            xb_add(&bar[XB_XGEN(b.x)], 1u);
            asm volatile("s_waitcnt vmcnt(0)" ::: "memory");
        } else {
            XB_SPIN(xb_ld(&bar[XB_XGEN(b.x)]) == gen, bar);
            __builtin_amdgcn_fence(__ATOMIC_ACQUIRE, "agent");
            asm volatile("s_waitcnt vmcnt(0)" ::: "memory");
        }
    }
    __syncthreads();
}

template <class Sched>
__device__ __forceinline__ void fill_rs_table(LAS float* T, const float* rsp, const Sched& S, int tid) {
    const int half = __builtin_amdgcn_readfirstlane(tid >> 8), lt = tid & 255;
    f32x4 a[8], b[8]; bool ok[8];
#pragma unroll
    for (int j = 0; j < 8; ++j) {
        pg8::Unit u; const int i = 2 * j + half;
        ok[j] = (i < RS_TABLE_UNITS) && S.next(i, u);
        const int pm = ok[j] ? u.pm : 0;
        const GAS float* p = (const GAS float*)rsp + ((size_t)pm * 256 + lt) * 8;
        a[j] = *(const GAS f32x4*)p; b[j] = *(const GAS f32x4*)(p + 4);
    }
#pragma unroll
    for (int j = 0; j < 8; ++j)
        if (ok[j]) T[(2 * j + half) * 256 + lt] = __builtin_amdgcn_rsqf((((a[j][0] + a[j][1]) + (a[j][2] + a[j][3])) + ((b[j][0] + b[j][1]) + (b[j][2] + b[j][3]))) * (1.0f / DM) + EPS);
    __syncthreads();
}

struct Args { const float* in[23]; float* out; unsigned char* ws; float inv[8]; int ph_lo, ph_hi; };

struct ConvJob { const float* W; bf16_t* WT; const float* scale; const float* kscale; int K, N, mode, roff, item; };
constexpr int CI_FF = (DM / 64) * (DFF / 32), CI_Q = (DM / 64) * (512 / 32), CI_WO = (512 / 64) * (DM / 32), CI_IN = (DM / 64) * (INW / 32), CI_OUT = (DM / 64) * (DM / 32), CI_PL = (512 / 64) * (512 / 32);
constexpr int CI_COMMON = 6 * CI_FF + 3 * CI_Q + CI_WO, CI_L0 = CI_COMMON + CI_IN + CI_OUT, CI_L1 = CI_COMMON + 4 * CI_PL;
__device__ __forceinline__ ConvJob conv_decode(const Args& a, int r) {
    int layer = 0; if (r >= CI_L0) { layer = 1; r -= CI_L0; }
    unsigned char* ws = a.ws + WS_WL + (size_t)layer * WL_STRIDE;
    const size_t FW = (size_t)DM * DFF;
    const float* nb = a.in[2] + (size_t)layer * 8 * DM;
    ConvJob j; j.scale = nullptr; j.kscale = nullptr; j.mode = 0; j.roff = 0; j.K = DM; j.N = DFF;
    if (r < CI_FF) { j.W = a.in[4] + layer * FW; j.WT = (bf16_t*)(ws + WO_W1A); j.mode = 1; j.kscale = nb; j.item = r; return j; } r -= CI_FF;
    if (r < CI_FF) { j.W = a.in[5] + layer * FW; j.WT = (bf16_t*)(ws + WO_W1A); j.mode = 2; j.kscale = nb; j.item = r; return j; } r -= CI_FF;
    if (r < CI_FF) { j.W = a.in[6] + layer * FW; j.WT = (bf16_t*)(ws + WO_W1D); j.K = DFF; j.N = DM; j.item = r; return j; } r -= CI_FF;
    if (r < CI_FF) { j.W = a.in[7] + layer * FW; j.WT = (bf16_t*)(ws + WO_W2A); j.mode = 1; j.kscale = nb + 6 * DM; j.item = r; return j; } r -= CI_FF;
    if (r < CI_FF) { j.W = a.in[8] + layer * FW; j.WT = (bf16_t*)(ws + WO_W2A); j.mode = 2; j.kscale = nb + 6 * DM; j.item = r; return j; } r -= CI_FF;
    if (r < CI_FF) { j.W = a.in[9] + layer * FW; j.WT = (bf16_t*)(ws + WO_W2D); j.K = DFF; j.N = DM; j.item = r; return j; } r -= CI_FF;
    j.N = 512;
    if (r < CI_Q) { j.W = a.in[10] + (size_t)layer * DM * 512; j.WT = (bf16_t*)(ws + WO_WQ); j.kscale = nb + 4 * DM; j.item = r; return j; } r -= CI_Q;
    if (r < CI_Q) { j.W = a.in[11] + (size_t)layer * DM * 512; j.WT = (bf16_t*)(ws + WO_WKV); j.item = r; return j; } r -= CI_Q;
    if (r < CI_Q) { j.W = a.in[12] + (size_t)layer * DM * 512; j.WT = (bf16_t*)(ws + WO_WKV); j.roff = 512; j.item = r; return j; } r -= CI_Q;
    if (r < CI_WO) { j.W = a.in[13] + (size_t)layer * 512 * DM; j.WT = (bf16_t*)(ws + WO_WO); j.K = 512; j.N = DM; j.item = r; return j; } r -= CI_WO;
    if (layer == 0) {
        if (r < CI_IN) { j.W = a.in[14]; j.WT = (bf16_t*)(ws + WO_WIN); j.N = INW; j.kscale = nb + 2 * DM; j.item = r; return j; } r -= CI_IN;
        j.W = a.in[15]; j.WT = (bf16_t*)(ws + WO_WOUT); j.N = DM; j.item = r; return j;
    }
    const int gi = r / CI_PL; r -= gi * CI_PL;
    j.W = a.in[21] + (size_t)gi * 512 * 512; j.WT = (bf16_t*)(ws + WO_WPOOL); j.K = 512; j.N = 512; j.roff = gi * 512; j.scale = a.in[22] + gi * 512; j.item = r; return j;
}
__device__ __forceinline__ void conv_load(const ConvJob& j, int lane, float (&v)[32]) {
    const int nblk = j.N / 32, kb = j.item / nblk, nb = j.item % nblk;
    const GAS float* Wg = (const GAS float*)j.W + (size_t)(64 * kb + (lane >> 5)) * j.N + 32 * nb + (lane & 31);
#pragma unroll
    for (int i = 0; i < 32; ++i) v[i] = Wg[(size_t)(2 * i) * j.N];
}
__device__ __forceinline__ void conv_finish(const ConvJob& j, LAS float* scr, int lane, const float (&v)[32]) {
    const int nblk = j.N / 32, kb = j.item / nblk, nb = j.item % nblk, k0 = 64 * kb, n0 = 32 * nb;
    const float sc = j.scale ? ((const GAS float*)j.scale)[n0 + (lane & 31)] : 1.0f;
#pragma unroll
    for (int i = 0; i < 32; ++i) scr[(2 * i + (lane >> 5)) * 33 + (lane & 31)] = v[i] * sc;
    asm volatile("s_waitcnt lgkmcnt(0)" ::: "memory");
    const int drow0 = (j.mode == 0) ? (j.roff + n0) : (256 * (n0 >> 7) + (n0 & 127) + (j.mode == 2 ? 128 : 0));
    const int c = lane & 7;
    f32x4 ka = (f32x4){1.f, 1.f, 1.f, 1.f}, kc = ka;
    if (j.kscale) { ka = *(const GAS f32x4*)((const GAS float*)j.kscale + k0 + 8 * c); kc = *(const GAS f32x4*)((const GAS float*)j.kscale + k0 + 8 * c + 4); }
#pragma unroll
    for (int q = 0; q < 4; ++q) { const int n = (lane >> 3) + 8 * q; const LAS float* s = scr + (8 * c) * 33 + n;
        u32x4 o; o.x = cvt_pk_bf16(s[0 * 33] * ka[0], s[1 * 33] * ka[1]); o.y = cvt_pk_bf16(s[2 * 33] * ka[2], s[3 * 33] * ka[3]); o.z = cvt_pk_bf16(s[4 * 33] * kc[0], s[5 * 33] * kc[1]); o.w = cvt_pk_bf16(s[6 * 33] * kc[2], s[7 * 33] * kc[3]);
        *(GAS u32x4*)((GAS bf16_t*)j.WT + (size_t)(drow0 + n) * j.K + k0 + 8 * c) = o; }
    asm volatile("s_waitcnt lgkmcnt(0)" ::: "memory");
}
__device__ __forceinline__ void conv_all(const Args& a, LAS unsigned char* lds, int wid, int lane, int gw, int ngw) {
    LAS float* scr = (LAS float*)(lds + wid * 16384);
    constexpr int NT = CI_L0 + CI_L1;
    for (int it = gw; it < NT; it += 2 * ngw) {
        const bool h1 = (it + ngw) < NT;
        const ConvJob j0 = conv_decode(a, it), j1 = conv_decode(a, h1 ? it + ngw : it);
        float v0[32], v1[32];
        conv_load(j0, lane, v0); conv_load(j1, lane, v1);
        asm volatile("" ::: "memory");
        conv_finish(j0, scr, lane, v0);
        if (h1) conv_finish(j1, scr, lane, v1);
    }
    for (int layer = 0; layer < 2; ++layer)
        norm_pass(a.in[1], nullptr, nullptr, nullptr, 0.f, nullptr, a.in[3] + layer * DM, (bf16_t*)(a.ws + WS_MEMN + (size_t)layer * 4 * MiB), MEMROWS, gw, ngw, lane);
}

__global__ void __launch_bounds__(512, 2) mega_fwd(Args a) {
    extern __shared__ __attribute__((aligned(16))) unsigned char lds_raw[];
    LAS unsigned char* lds = (LAS unsigned char*)lds_raw;
    cg::grid_group grid = cg::this_grid();
    const int tid = threadIdx.x, lane = tid & 63, wid = __builtin_amdgcn_readfirstlane(tid >> 6);
    const int G = gridDim.x, bx = blockIdx.x;
    const int gw = bx * 8 + wid, ngw = G * 8;
    unsigned char* ws = a.ws;
    bf16_t* Hb = (bf16_t*)(ws + WS_H); float* RS = (float*)(ws + WS_RS);
    bf16_t* HID = (bf16_t*)(ws + WS_HID); bf16_t* Zb = (bf16_t*)(ws + WS_Z); bf16_t* CAT = (bf16_t*)(ws + WS_CAT); bf16_t* POOLB = (bf16_t*)(ws + WS_POOL);
    bf16_t* Qb = (bf16_t*)(ws + WS_Q); bf16_t* Ob = (bf16_t*)(ws + WS_O);
    f32x2* rope = (f32x2*)(ws + WS_ROPE); f32x2* sst = (f32x2*)(ws + WS_SST); bf16_t* SGUW = (bf16_t*)(ws + WS_SGUW);
    const float* norms = a.in[2];
    const int lo = a.ph_lo, hi = a.ph_hi;
    int gp = 0;
    volatile LAS unsigned* MISC = (volatile LAS unsigned*)(lds + LDS_BYTES - 64);
    if (tid < 16) MISC[tid] = 0u;
    __syncthreads();
    XcdBarrier xbar = xcd_barrier_post((unsigned*)ws, MISC);
#define SEAM() do { if (gp + 1 < hi) { if (a.inv[0] < 0.f) grid.sync(); else xcd_barrier(xbar); } } while (0)
#define SEAM_X() do { if (gp + 1 < hi) xcd_barrier(xbar); } while (0)

    if (gp >= lo && gp < hi) {
        prep_pass(a.in[0], Hb, RS, MTOK, gw, ngw, lane);
        conv_all(a, lds, wid, lane, gw, ngw);
        for (int idx = bx * 512 + tid; idx < SEQ * 8; idx += G * 512) {
            const int pos = idx >> 3, k = idx & 7;
            const float ang = (float)pos * a.inv[k];
            double rev = (double)ang * 0.15915494309189535; rev -= floor(rev);
            const float fr = (float)rev;
            ((GAS f32x2*)rope)[idx] = (f32x2){__builtin_amdgcn_cosf(fr), __builtin_amdgcn_sinf(fr)};
        }
        for (int idx = bx * 512 + tid; idx < MTOK * 8; idx += G * 512) ((GAS unsigned long long*)(ws + WS_XB))[idx] = 0ull;
        for (int idx = bx * 512 + tid; idx < 8 * 128 * 128; idx += G * 512) {
            const int i = (idx >> 7) & 127, j = idx & 127;
            const float v = (j <= i) ? ((const GAS float*)a.in[19])[idx] : 0.f;
            ((GAS bf16_t*)SGUW)[idx] = (bf16_t)(cvt_pk_bf16(v, 0.f) & 0xffffu);
        }
        SEAM();
    }
    ++gp;

#pragma unroll 1
    for (int layer = 0; layer < 2; ++layer) {
        const float* gl = norms + layer * 8 * DM;
        const unsigned char* wl = ws + WS_WL + (size_t)layer * WL_STRIDE;
#pragma unroll 1
        for (int p = 0; p < 10; ++p) {
            if ((layer == 1 && p == 3) || p == 6) continue;
            if (gp >= lo && gp < hi) {
                const int tid = fresh_tid(), lane = tid & 63, wid = __builtin_amdgcn_readfirstlane(tid >> 6);
                if (p == 0 || p == 8) {
                    pg8::Gemm g{Hb, (const bf16_t*)(wl + (p == 0 ? WO_W1A : WO_W2A)), MTOK, 2 * DFF, DM, DM, DM, 0, 0u};
                    pg8::StaticOrder S; S.init(MTOK, 2 * DFF, G, bx);
                    fill_rs_table((LAS float*)(lds + XL_OFF), RS, S, tid);
                    pg8::EpiSwiglu E{HID, RS, (const LAS float*)(lds + XL_OFF)};
                    pg8::gemm_phase<pg8::EpiSwiglu, pg8::StaticOrder>(lds, g, S, E);
                } else if (p == 1 || p == 9 || p == 4 || p == 7) {
                    pg8::Gemm g;
                    if (p == 1 || p == 9) g = pg8::Gemm{HID, (const bf16_t*)(wl + (p == 1 ? WO_W1D : WO_W2D)), MTOK, DM, DFF, DFF, DFF, 0, 0u};
                    else if (p == 7) g = pg8::Gemm{Ob, (const bf16_t*)(wl + WO_WO), MTOK, DM, 512, 512, 512, 0, 0u};
                    else if (layer == 0) g = pg8::Gemm{CAT, (const bf16_t*)(wl + WO_WOUT), MTOK, DM, DM, DM, DM, 0, 0u};
                    else g = pg8::Gemm{POOLB, (const bf16_t*)(wl + WO_WPOOL), MTOK, DM, 512, DM, 512, 1, 1024u};
                    const int gi = (p == 1) ? 1 : (p == 4) ? 3 : (p == 7) ? 5 : 7;
                    const int seq = layer * 4 + (gi >> 1);
                    const bool final_ = (p == 9 && layer == 1);
                    pg8::PanelOrder S; S.init(MTOK, G, bx);
                    pg8::EpiNorm E{Hb, final_ ? a.out : nullptr, RS, gl + gi * DM, (p == 1 || p == 9) ? 0.5f : 1.0f,
                                   (float*)(ws + WS_XB), (unsigned*)(ws + WS_CNT), (unsigned)(seq + 1), lds + XL_OFF};
                    pg8::gemm_phase<pg8::EpiNorm, pg8::PanelOrder>(lds, g, S, E);
                } else if (p == 2) {
                    if (layer == 0) {
                        pg8::Gemm g{Hb, (const bf16_t*)(wl + WO_WIN), MTOK, INW, DM, DM, DM, 0, 0u};
                        pg8::StaticOrder S; S.init(MTOK, INW, G, bx);
                        fill_rs_table((LAS float*)(lds + XL_OFF), RS, S, tid);
                        pg8::EpiAct E{Zb, INW, 5, 9, sst, RS, (const LAS float*)(lds + XL_OFF)};
                        for (int k = 0; k < 3; ++k) {
                            if (k > 0) {
                                const unsigned char* wk = ws + WS_WL + (size_t)(k - 1) * WL_STRIDE;
                                g = pg8::Gemm{(const bf16_t*)(ws + WS_MEMN + (size_t)(k - 1) * 4 * MiB), (const bf16_t*)(wk + WO_WKV), MEMROWS, 1024, DM, DM, DM, 0, 0u};
                                S.init(MEMROWS, 1024, G, G > 96 ? (bx + G - 64 - 16 * (k - 1)) % G : bx);
                                E = pg8::EpiAct{(bf16_t*)(ws + WS_KV + (size_t)(k - 1) * 2 * MiB), 1024, 1 << 30, 1 << 30, sst, nullptr, nullptr};
                            }
                            pg8::gemm_phase<pg8::EpiAct, pg8::StaticOrder>(lds, g, S, E);
                        }
                    } else {
                        for (int u = bx; u < MTOK / 32; u += G) pool_unit(lds, Hb, RS, gl + 2 * DM, POOLB, u, tid);
                    }
                } else if (p == 3) {
                    for (int u = bx; u < 256 + 1024; u += G) {
                        if (u < 256) attn_unit(lds, Zb, CAT, rope, a.in[16], u, tid, wid, lane);
                        else sgu_unit(lds, Zb, CAT, sst, SGUW, a.in[17], a.in[18], a.in[20], u - 256, tid, wid, lane);
                    }
                } else if (p == 5) {
                    pg8::Gemm g{Hb, (const bf16_t*)(wl + WO_WQ), MTOK, 512, DM, DM, DM, 0, 0u};
                    pg8::StaticOrder S; S.init(MTOK, 1024, G, bx);
                    fill_rs_table((LAS float*)(lds + XL_OFF), RS, S, tid);
                    pg8::EpiHalf E{Qb, 512, RS, (const LAS float*)(lds + XL_OFF)};
                    pg8::gemm_phase<pg8::EpiHalf, pg8::StaticOrder, true>(lds, g, S, E);
                    const bf16_t* kvl = (const bf16_t*)(ws + WS_KV + (size_t)layer * 2 * MiB);
                    pg8::Unit u;
                    for (int i = 0; S.next(i, u); ++i) xattn_unit(lds, Qb, kvl, Ob, ((u.pm >> 4) * 4 + u.pn) * 16 + (u.pm & 15), tid, wid, lane);
                }
                if (!(layer == 1 && p == 9)) SEAM_X();
            }
            ++gp;
        }
    }
#undef SEAM
#undef SEAM_X
}

extern "C" void kernel_launch(void* const* d_in, const int* in_sizes, int n_in, void* d_out, int out_size, void* d_ws, size_t ws_size, hipStream_t stream) {
    static int grid = 0;
    if (grid == 0) {
        if (n_in != 23 || out_size != MTOK * DM || ws_size < WS_END) { fprintf(stderr, "kernel_launch: unexpected problem (n_in %d, out %d, ws %zu)\n", n_in, out_size, ws_size); grid = -1; return; }
        int dev = 0, cus = 0, per_cu = 0;
        hipGetDevice(&dev);
        hipDeviceGetAttribute(&cus, hipDeviceAttributeMultiprocessorCount, dev);
        if (hipFuncSetAttribute((const void*)mega_fwd, hipFuncAttributeMaxDynamicSharedMemorySize, LDS_BYTES) != hipSuccess) { fprintf(stderr, "kernel_launch: hipFuncSetAttribute failed\n"); grid = -1; return; }
        if (hipOccupancyMaxActiveBlocksPerMultiprocessor(&per_cu, (const void*)mega_fwd, 512, LDS_BYTES) != hipSuccess || per_cu < 1) { fprintf(stderr, "kernel_launch: occupancy query gave %d\n", per_cu); per_cu = 1; }
        (void)hipGetLastError();
        grid = cus * per_cu; grid -= grid % 8;
        fprintf(stderr, "kernel_launch: grid %d (cus %d x %d)\n", grid, cus, per_cu);
    }
    if (grid < 0) return;
    if (hipMemsetAsync(d_ws, 0, 65536, stream) != hipSuccess) { fprintf(stderr, "kernel_launch: memset failed\n"); return; }
    Args a{};
    for (int i = 0; i < 23; ++i) a.in[i] = (const float*)d_in[i];
    a.out = (float*)d_out; a.ws = (unsigned char*)d_ws;
    for (int k = 0; k < 8; ++k) a.inv[k] = (float)pow(500000.0, -(double)k / 8.0);
    a.ph_lo = 0; a.ph_hi = 1000;
    void* args[] = {&a};
    hipError_t e = hipLaunchCooperativeKernel((const void*)mega_fwd, dim3(grid), dim3(512), args, LDS_BYTES, stream);
    if (e != hipSuccess) fprintf(stderr, "kernel_launch: cooperative launch failed: %s (grid %d)\n", hipGetErrorString(e), grid);
}
```

```cpp
#include <hip/hip_runtime.h>
#include <hip/hip_cooperative_groups.h>
#include <cstdio>
#include <cstdint>
#include <cmath>
namespace cg = cooperative_groups;

#define LAS __attribute__((address_space(3)))
#define GAS __attribute__((address_space(1)))
typedef unsigned short bf16_t;
typedef short bf16x8 __attribute__((ext_vector_type(8)));
typedef short s16x4 __attribute__((ext_vector_type(4)));
typedef float f32x4 __attribute__((ext_vector_type(4)));
typedef float f32x2 __attribute__((ext_vector_type(2)));
typedef unsigned u32x4 __attribute__((ext_vector_type(4)));
typedef unsigned u32x2 __attribute__((ext_vector_type(2)));

constexpr int MTOK = 16384, DM = 2048, DFF = 5632, SEQ = 4096, MEMROWS = 1024;
constexpr int INW = 3328;
constexpr float EPS = 1e-6f;

constexpr size_t MiB = 1u << 20;
constexpr size_t WS_CNT  = 16384;
constexpr size_t WS_ROPE = 1 * MiB;
constexpr size_t WS_XB   = 2 * MiB;
constexpr size_t WS_RS   = 3 * MiB;
constexpr size_t WS_SST  = 4 * MiB;
constexpr size_t WS_SGUW = 6 * MiB;
constexpr size_t WS_MEMN = 8 * MiB;
constexpr size_t WS_Q    = 16 * MiB;
constexpr size_t WS_O    = 32 * MiB;
constexpr size_t WS_KV   = 48 * MiB;
constexpr size_t WS_H    = 64 * MiB;
constexpr size_t WS_HID  = 128 * MiB;
constexpr size_t WS_Z    = 128 * MiB;
constexpr size_t WS_CAT  = 232 * MiB;
constexpr size_t WS_POOL = 128 * MiB;
constexpr size_t WS_WL   = 304 * MiB;
constexpr size_t WL_STRIDE = 164 * MiB;
constexpr size_t WO_W1A = 0, WO_W1D = 44 * MiB, WO_W2A = 66 * MiB, WO_W2D = 110 * MiB, WO_WQ = 132 * MiB, WO_WKV = 134 * MiB, WO_WO = 138 * MiB,
                 WO_WIN = 140 * MiB, WO_WOUT = 154 * MiB, WO_WPOOL = 140 * MiB;
constexpr size_t WS_END  = WS_WL + 2 * WL_STRIDE;

constexpr int LDS_BYTES = 147456;
constexpr int XL_OFF = 131072;

typedef __bf16 bf16x2_t __attribute__((ext_vector_type(2)));
__device__ __forceinline__ unsigned cvt_pk_bf16(float lo, float hi) { const f32x2 v = {lo, hi}; const bf16x2_t b = __builtin_convertvector(v, bf16x2_t); return __builtin_bit_cast(unsigned, b); }
__device__ __forceinline__ float bflo(unsigned w) { return __uint_as_float(w << 16); }
__device__ __forceinline__ float bfhi(unsigned w) { return __uint_as_float(w & 0xffff0000u); }
__device__ __forceinline__ float wave_sum(float v) {
#pragma unroll
    for (int o = 1; o < 64; o <<= 1) v += __shfl_xor(v, o);
    return v;
}
__device__ __forceinline__ float gelu_tanh(float x) {
    const float inner = 1.5957691216057308f * (x + 0.044715f * x * x * x);
    return x * __builtin_amdgcn_rcpf(1.0f + __expf(-inner));
}
__device__ __forceinline__ float silu_f(float x) { return x * __builtin_amdgcn_rcpf(1.0f + __expf(-x)); }
__device__ __forceinline__ int fresh_tid() { int t = threadIdx.x; asm volatile("" : "+v"(t)); return t; }
__device__ __forceinline__ float row_rs(const float* rsp, int row) {
    const f32x4 a = *(const GAS f32x4*)((const GAS float*)rsp + (size_t)row * 8), b = *(const GAS f32x4*)((const GAS float*)rsp + (size_t)row * 8 + 4);
    return __builtin_amdgcn_rsqf((((a[0] + a[1]) + (a[2] + a[3])) + ((b[0] + b[1]) + (b[2] + b[3]))) * (1.0f / DM) + EPS);
}
constexpr int RS_TABLE_UNITS = 15;
__device__ __forceinline__ float rs_lookup(const LAS float* T, const float* rsp, int ord, int pm, int lrow) {
    return (ord < RS_TABLE_UNITS) ? T[ord * 256 + lrow] : row_rs(rsp, pm * 256 + lrow);
}
__device__ __forceinline__ void rs_lookup8(float (&rsv)[8], const LAS float* T, const float* rsp, int ord, int pm, int lrow0) {
    if (ord < RS_TABLE_UNITS) {
#pragma unroll
        for (int q = 0; q < 8; ++q) rsv[q] = T[ord * 256 + lrow0 + (q >> 2) * 128 + (q & 3) * 16];
    } else {
#pragma unroll
        for (int q = 0; q < 8; ++q) rsv[q] = row_rs(rsp, pm * 256 + lrow0 + (q >> 2) * 128 + (q & 3) * 16);
    }
}
#define MFMA16(a, b, c) __builtin_amdgcn_mfma_f32_16x16x32_bf16((a), (b), (c), 0, 0, 0)

namespace pg8 {
constexpr int BM = 256, BK = 64, HALF = 128, HTB = HALF * BK * 2, STAGE_BYTES = 8 * HTB, NXCD = 8, WGM = 8;
__host__ __device__ __forceinline__ int lds_byte(int r, int c) { const int st = (r >> 4) * 2 + (c >> 5), rr = r & 15, cc = c & 31, ob = rr * 64 + cc * 2; return st * 1024 + (ob ^ (((ob >> 9) & 1) << 5)); }
__host__ __device__ __forceinline__ void stage_rc(int b, int& R, int& C) { const int st = b / 1024, sb = b % 1024, swz = sb ^ (((sb >> 9) & 1) << 5); R = (st >> 1) * 16 + swz / 64; C = (st & 1) * 32 + (swz % 64) / 2; }
__host__ __device__ __forceinline__ int perm32(int rho) { const int n = rho >> 4, i = rho & 15; return 8 * (i >> 2) + 4 * n + (i & 3); }

struct Unit { int pm, pn, ord; };
struct Gemm { const bf16_t* A; const bf16_t* Bt; int M, N, K, lda, ldb, a_shift; unsigned a_stride; };

struct StaticOrder {
    int nM, nN, nwg, G, c;
    __device__ void init(int M, int N, int G_, int c_) { nM = M / BM; nN = N / BM; nwg = nM * nN; G = G_; c = c_; }
    __device__ bool next(int i, Unit& u) const {
        const long L = (long)i * G + c; if (L >= nwg) return false;
        int wgid = (int)L; { const int q = nwg / NXCD, r = nwg % NXCD, xcd = wgid % NXCD, off = wgid / NXCD; wgid = (xcd < r ? xcd * (q + 1) : r * (q + 1) + (xcd - r) * q) + off; }
        const int nig = WGM * nN, gid = wgid / nig, fm = gid * WGM, gsz = (nM - fm) < WGM ? (nM - fm) : WGM;
        u.pm = fm + ((wgid % nig) % gsz); u.pn = (wgid % nig) / gsz; return true;
    }
};


struct EpiAct {
    bf16_t* O; int ldc; int gelu_from, stat_from; f32x2* st;
    const float* rs; const LAS float* T;
    __device__ __forceinline__ void operator()(const f32x4 (&acc)[2][2][4][2], const Unit& u, int wr, int wc, int fr, int fq) const {
        const int row0 = u.pm * BM + wr * 64 + fr, col0 = u.pn * BM + wc * 32 + 8 * fq;
        const bool do_gelu = u.pn >= gelu_from, do_stat = u.pn >= stat_from;
        float rsv8[8];
        if (rs) rs_lookup8(rsv8, T, rs, u.ord, u.pm, wr * 64 + fr);
        else {
#pragma unroll
            for (int q = 0; q < 8; ++q) rsv8[q] = 1.0f;
        }
#pragma unroll
        for (int ai = 0; ai < 2; ++ai)
#pragma unroll
            for (int m = 0; m < 4; ++m) {
                const int row = row0 + ai * HALF + m * 16;
                GAS bf16_t* rowp = (GAS bf16_t*)O + (size_t)row * ldc + col0;
                const float rsv = rsv8[ai * 4 + m];
                float s1 = 0.f, s2 = 0.f;
#pragma unroll
                for (int bj = 0; bj < 2; ++bj) {
                    f32x4 v0 = acc[ai][bj][m][0] * rsv, v1 = acc[ai][bj][m][1] * rsv;
                    if (do_gelu) {
#pragma unroll
                        for (int e = 0; e < 4; ++e) { v0[e] = gelu_tanh(v0[e]); v1[e] = gelu_tanh(v1[e]); }
                    }
                    if (do_stat) {
#pragma unroll
                        for (int e = 0; e < 4; ++e) { s1 += v0[e] + v1[e]; s2 += v0[e] * v0[e] + v1[e] * v1[e]; }
                    }
                    u32x4 w; w.x = cvt_pk_bf16(v0[0], v0[1]); w.y = cvt_pk_bf16(v0[2], v0[3]); w.z = cvt_pk_bf16(v1[0], v1[1]); w.w = cvt_pk_bf16(v1[2], v1[3]);
                    *(GAS u32x4*)(rowp + bj * HALF) = w;
                }
                if (do_stat) {
                    s1 += __shfl_xor(s1, 16); s1 += __shfl_xor(s1, 32); s2 += __shfl_xor(s2, 16); s2 += __shfl_xor(s2, 32);
                    if (fq == 0) ((GAS f32x2*)st)[(size_t)((u.pn - stat_from) * 4 + wc) * MTOK + row] = (f32x2){s1, s2};
                }
            }
    }
};
struct EpiHalf {
    bf16_t* O; int ldc; const float* rs; const LAS float* T;
    __device__ __forceinline__ void operator()(const f32x4 (&acc)[2][2][4][2], const Unit& u, int wr, int wc, int fr, int fq) const {
        const int row0 = u.pm * BM + wr * 64 + fr, col0 = u.pn * HALF + wc * 32 + 8 * fq;
        float rsv8[8];
        rs_lookup8(rsv8, T, rs, u.ord, u.pm, wr * 64 + fr);
#pragma unroll
        for (int ai = 0; ai < 2; ++ai)
#pragma unroll
            for (int m = 0; m < 4; ++m) {
                const int row = row0 + ai * HALF + m * 16;
                const float rsv = rsv8[ai * 4 + m];
                const f32x4 v0 = acc[ai][0][m][0] * rsv, v1 = acc[ai][0][m][1] * rsv;
                u32x4 w; w.x = cvt_pk_bf16(v0[0], v0[1]); w.y = cvt_pk_bf16(v0[2], v0[3]); w.z = cvt_pk_bf16(v1[0], v1[1]); w.w = cvt_pk_bf16(v1[2], v1[3]);
                *(GAS u32x4*)((GAS bf16_t*)O + (size_t)row * ldc + col0) = w;
            }
    }
};
struct EpiSwiglu {
    bf16_t* O; const float* rs; const LAS float* T;
    __device__ __forceinline__ void operator()(const f32x4 (&acc)[2][2][4][2], const Unit& u, int wr, int wc, int fr, int fq) const {
        const int row0 = u.pm * BM + wr * 64 + fr, col0 = u.pn * HALF + wc * 32 + 8 * fq;
        float rsv[8], irs2[8];
        rs_lookup8(rsv, T, rs, u.ord, u.pm, wr * 64 + fr);
#pragma unroll
        for (int q = 0; q < 8; ++q) irs2[q] = __builtin_amdgcn_rcpf(rsv[q] * rsv[q]);
#pragma unroll
        for (int ai = 0; ai < 2; ++ai)
#pragma unroll
            for (int mp = 0; mp < 2; ++mp) {
                f32x2 gg[8], ee[8];
#pragma unroll
                for (int q = 0; q < 8; ++q) {
                    const int m = 2 * mp + (q >> 2), n = (q >> 1) & 1, h2 = q & 1;
                    gg[q] = (f32x2){acc[ai][0][m][n][2 * h2], acc[ai][0][m][n][2 * h2 + 1]};
                    const f32x2 a2 = gg[q] * (rsv[ai * 4 + m] * -1.4426950408889634f);
                    ee[q].x = __builtin_amdgcn_exp2f(a2.x); ee[q].y = __builtin_amdgcn_exp2f(a2.y);
                }
#pragma unroll
                for (int q = 0; q < 8; ++q) { const float ir = irs2[ai * 4 + 2 * mp + (q >> 2)]; const f32x2 d2 = ee[q] * ir + ir;
                    ee[q].x = __builtin_amdgcn_rcpf(d2.x); ee[q].y = __builtin_amdgcn_rcpf(d2.y); }
                u32x4 w[2];
#pragma unroll
                for (int q = 0; q < 8; ++q) {
                    const int m = 2 * mp + (q >> 2), n = (q >> 1) & 1, h2 = q & 1;
                    const f32x2 u2 = {acc[ai][1][m][n][2 * h2], acc[ai][1][m][n][2 * h2 + 1]};
                    const f32x2 o2 = (gg[q] * u2) * ee[q];
                    w[q >> 2][(q & 3)] = cvt_pk_bf16(o2.x, o2.y);
                }
#pragma unroll
                for (int k = 0; k < 2; ++k) *(GAS u32x4*)((GAS bf16_t*)O + (size_t)(row0 + ai * HALF + (2 * mp + k) * 16) * DFF + col0) = w[k];
            }
    }
};
struct PanelOrder {
    int nwg, G, vcu;
    __device__ void init(int M, int G_, int c_) { nwg = (M / BM) * 8; G = G_; vcu = (c_ % 8) * (G_ / 8) + c_ / 8; }
    __device__ bool next(int i, Unit& u) const { const long L = (long)i * G + vcu; if (L >= nwg) return false; u.pm = (int)(L >> 3); u.pn = (int)(L & 7); return true; }
};
struct EpiNorm {
    bf16_t* XB; float* OUT; float* rs; const float* g_post; float wgt;
    float* xb; unsigned* cnt; unsigned want; LAS unsigned char* xl;
    __device__ __forceinline__ void exchange_post(const f32x4 (&v)[2][2][4][2], const Unit& u, int wr, int wc, int fr, int fq, int wid, int lane, int which) const {
        LAS float* P = (LAS float*)xl;
#pragma unroll
        for (int ai = 0; ai < 2; ++ai)
#pragma unroll
            for (int m = 0; m < 4; ++m) {
                float q = 0.f;
#pragma unroll
                for (int bj = 0; bj < 2; ++bj)
#pragma unroll
                    for (int n = 0; n < 2; ++n) { const f32x4 x = v[ai][bj][m][n]; q += (x[0] * x[0] + x[1] * x[1]) + (x[2] * x[2] + x[3] * x[3]); }
                q += __shfl_xor(q, 16); q += __shfl_xor(q, 32);
                if (fq == 0) P[(ai * HALF + wr * 64 + m * 16 + fr) * 4 + wc] = q;
            }
        asm volatile("s_waitcnt lgkmcnt(0)" ::: "memory"); __builtin_amdgcn_s_barrier(); asm volatile("" ::: "memory");
        const int row = wid * 32 + (lane & 31);
        unsigned long long* slots = (unsigned long long*)xb + ((size_t)u.pm * BM + row) * 8;
        if (lane < 32) {
            const float t = (P[row * 4 + 0] + P[row * 4 + 1]) + (P[row * 4 + 2] + P[row * 4 + 3]);
            __hip_atomic_store(slots + u.pn, ((unsigned long long)want << 32) | (unsigned long long)__float_as_uint(t), __ATOMIC_RELAXED, __HIP_MEMORY_SCOPE_AGENT);
        }
    }
    __device__ __forceinline__ void exchange_wait(const Unit& u, int wid, int lane, int which, float scale) const {
        LAS float* S = (LAS float*)(xl + 4096);
        const int row = wid * 32 + (lane & 31);
        unsigned long long* slots = (unsigned long long*)xb + ((size_t)u.pm * BM + row) * 8;
        float t = 0.f; bool done = lane >= 32;
        for (unsigned it = 0; it < (1u << 15); ++it) {
            if (!done) {
                bool ok = true; float acc = 0.f;
#pragma unroll
                for (int h4 = 0; h4 < 2; ++h4) {
                    unsigned long long w[4];
#pragma unroll
                    for (int k = 0; k < 4; ++k) w[k] = __hip_atomic_load(slots + 4 * h4 + k, __ATOMIC_RELAXED, __HIP_MEMORY_SCOPE_AGENT);
#pragma unroll
                    for (int k = 0; k < 4; ++k) { ok = ok && ((unsigned)(w[k] >> 32) == want); acc += __uint_as_float((unsigned)w[k]); }
                    asm volatile("" ::: "memory");
                }
                if (ok) { t = acc; done = true; }
            }
            if (!__any(!done)) break;
            __builtin_amdgcn_s_sleep(1);
        }
        if (lane < 32) S[row] = scale * rsqrtf(t * (1.0f / DM) + EPS);
        asm volatile("s_waitcnt vmcnt(0) lgkmcnt(0)" ::: "memory"); __builtin_amdgcn_s_barrier(); asm volatile("" ::: "memory");
    }
    __device__ __forceinline__ void publish(const f32x4 (&v)[2][2][4][2], const Unit& u, int wr, int wc, int fr, int fq, int wid, int lane) const {
        LAS float* P = (LAS float*)xl;
#pragma unroll
        for (int ai = 0; ai < 2; ++ai)
#pragma unroll
            for (int m = 0; m < 4; ++m) {
                float q = 0.f;
#pragma unroll
                for (int bj = 0; bj < 2; ++bj)
#pragma unroll
                    for (int n = 0; n < 2; ++n) { const f32x4 x = v[ai][bj][m][n]; q += (x[0] * x[0] + x[1] * x[1]) + (x[2] * x[2] + x[3] * x[3]); }
                q += __shfl_xor(q, 16); q += __shfl_xor(q, 32);
                if (fq == 0) P[(ai * HALF + wr * 64 + m * 16 + fr) * 4 + wc] = q;
            }
        asm volatile("s_waitcnt lgkmcnt(0)" ::: "memory"); __builtin_amdgcn_s_barrier(); asm volatile("" ::: "memory");
        const int row = wid * 32 + (lane & 31);
        if (lane < 32) ((GAS float*)rs)[((size_t)u.pm * BM + row) * 8 + u.pn] = (P[row * 4 + 0] + P[row * 4 + 1]) + (P[row * 4 + 2] + P[row * 4 + 3]);
    }
    __device__ __forceinline__ void operator()(f32x4 (&acc)[2][2][4][2], const Unit& u, int wr, int wc, int fr_in, int fq_in) const {
        int fr = fr_in, fq = fq_in; asm volatile("" : "+v"(fr), "+v"(fq));
        const int wid = wr * 4 + wc, lane = fq * 16 + fr;
        const LAS float* S = (const LAS float*)(xl + 4096);
        const int col0 = u.pn * BM + wc * 32 + 8 * fq;
        exchange_post(acc, u, wr, wc, fr, fq, wid, lane, 0);
        u32x4 xv[2][4][2];
#pragma unroll
        for (int ai = 0; ai < 2; ++ai)
#pragma unroll
            for (int m = 0; m < 3; ++m)
#pragma unroll
                for (int bj = 0; bj < 2; ++bj)
                    xv[ai][m][bj] = *(const GAS u32x4*)((const GAS bf16_t*)XB + ((size_t)u.pm * BM + ai * HALF + wr * 64 + m * 16 + fr) * DM + col0 + bj * HALF);
        exchange_wait(u, wid, lane, 0, wgt);
#pragma unroll
        for (int ai = 0; ai < 2; ++ai)
#pragma unroll
            for (int bj = 0; bj < 2; ++bj)
                xv[ai][3][bj] = *(const GAS u32x4*)((const GAS bf16_t*)XB + ((size_t)u.pm * BM + ai * HALF + wr * 64 + 3 * 16 + fr) * DM + col0 + bj * HALF);
        f32x4 gp[2][2];
#pragma unroll
        for (int bj = 0; bj < 2; ++bj)
#pragma unroll
            for (int n = 0; n < 2; ++n) gp[bj][n] = *(const GAS f32x4*)((const GAS float*)g_post + col0 + bj * HALF + 4 * n);
#pragma unroll
        for (int ai = 0; ai < 2; ++ai)
#pragma unroll
            for (int m = 0; m < 4; ++m) {
                const int r = ai * HALF + wr * 64 + m * 16 + fr; const float sr = S[r];
                const size_t off = ((size_t)u.pm * BM + r) * DM + col0;
#pragma unroll
                for (int bj = 0; bj < 2; ++bj) {
                    const u32x4 xw = xv[ai][m][bj];
                    const f32x4 x0 = (f32x4){bflo(xw.x), bfhi(xw.x), bflo(xw.y), bfhi(xw.y)}, x1 = (f32x4){bflo(xw.z), bfhi(xw.z), bflo(xw.w), bfhi(xw.w)};
                    const f32x4 o0 = x0 + acc[ai][bj][m][0] * gp[bj][0] * sr, o1 = x1 + acc[ai][bj][m][1] * gp[bj][1] * sr;
                    acc[ai][bj][m][0] = o0; acc[ai][bj][m][1] = o1;
                    if (OUT) { *(GAS f32x4*)((GAS float*)OUT + off + bj * HALF) = o0; *(GAS f32x4*)((GAS float*)OUT + off + bj * HALF + 4) = o1; }
                    else { u32x4 w; w.x = cvt_pk_bf16(o0[0], o0[1]); w.y = cvt_pk_bf16(o0[2], o0[3]); w.z = cvt_pk_bf16(o1[0], o1[1]); w.w = cvt_pk_bf16(o1[2], o1[3]);
                           *(GAS u32x4*)((GAS bf16_t*)XB + off + bj * HALF) = w; }
                }
            }
        if (!OUT) publish(acc, u, wr, wc, fr, fq, wid, lane);
    }
};

struct NoPre { __device__ __forceinline__ void operator()() const {} };
template <class Sched>
struct RsFill {
    LAS float* T; const float* rsp; const Sched* S; int tid;
    __device__ __forceinline__ void operator()() const {
        const int half = __builtin_amdgcn_readfirstlane(tid >> 8), lt = tid & 255;
        f32x4 a[8], b[8]; bool ok[8];
#pragma unroll
        for (int j = 0; j < 8; ++j) {
            Unit u; const int i = 2 * j + half;
            ok[j] = (i < 15) && S->next(i, u);
            const int pm = ok[j] ? u.pm : 0;
            const GAS float* p = (const GAS float*)rsp + ((size_t)pm * 256 + lt) * 8;
            a[j] = *(const GAS f32x4*)p; b[j] = *(const GAS f32x4*)(p + 4);
        }
#pragma unroll
        for (int j = 0; j < 8; ++j)
            if (ok[j]) T[(2 * j + half) * 256 + lt] = __builtin_amdgcn_rsqf((((a[j][0] + a[j][1]) + (a[j][2] + a[j][3])) + ((b[j][0] + b[j][1]) + (b[j][2] + b[j][3]))) * (1.0f / DM) + EPS);
    }
};
template <class Epi, class Sched, bool HALFN = false, class Pre = NoPre>
__device__ __forceinline__ void gemm_phase(LAS unsigned char* lds, const Gemm g, const Sched& S, const Epi& E, const Pre& pre = Pre()) {
    const int tid = fresh_tid(), wid = __builtin_amdgcn_readfirstlane(tid >> 6), lane = tid & 63, wr = wid >> 2, wc = wid & 3, fr = lane & 15, fq = lane >> 4;
    const int nt = g.K / BK;
    unsigned voffA[2], voffB[2];
#pragma unroll
    for (int i = 0; i < 2; ++i) { int R, C; stage_rc(tid * 16 + i * 8192, R, C); const int Rb = (R & ~31) + perm32(R & 31);
        voffA[i] = (unsigned)(R * g.lda + C) * 2u; voffB[i] = (unsigned)(Rb * g.ldb + C) * 2u; }
    const size_t kstep = (size_t)(BK * 2);
    const size_t hA = (size_t)HALF * g.lda * 2, hB = (size_t)HALF * g.ldb * 2, tA = 2 * hA, tB = HALFN ? hB : 2 * hB;
    const unsigned ldsw = (unsigned)wid * 1024u;
    const int aoff = lds_byte(wr * 64 + fr, fq * 8), boff = lds_byte(wc * 32 + fr, fq * 8);
#define PG8_SA(b, h) (((b) * 2 + (h)) * HTB)
#define PG8_SB(b, h) ((4 + (b) * 2 + (h)) * HTB)
#define PG8_STAGE(bufoff, gbase, voff) do { _Pragma("unroll") for (int _i = 0; _i < 2; ++_i) \
        __builtin_amdgcn_global_load_lds((const GAS unsigned*)((const GAS char*)(gbase) + (voff)[_i]), (LAS unsigned*)(lds + (bufoff) + ldsw + _i * 8192), 16, 0, 0); } while (0)
#define PG8_LDA(dst, b, h) do { _Pragma("unroll") for (int m = 0; m < 4; ++m) _Pragma("unroll") for (int k = 0; k < 2; ++k) dst[m][k] = *(const LAS bf16x8*)(lds + PG8_SA(b, h) + aoff + m * 2048 + k * 1024); } while (0)
#define PG8_LDB(dst, b, h) do { _Pragma("unroll") for (int n = 0; n < 2; ++n) _Pragma("unroll") for (int k = 0; k < 2; ++k) dst[n][k] = *(const LAS bf16x8*)(lds + PG8_SB(b, h) + boff + n * 2048 + k * 1024); } while (0)
#define PG8_MMA(ai, bj, At, Bt) do { __builtin_amdgcn_s_setprio(1); _Pragma("unroll") for (int m = 0; m < 4; ++m) _Pragma("unroll") for (int n = 0; n < 2; ++n) _Pragma("unroll") for (int k = 0; k < 2; ++k) \
        acc[ai][bj][m][n] = __builtin_amdgcn_mfma_f32_16x16x32_bf16(Bt[n][k], At[m][k], acc[ai][bj][m][n], 0, 0, 0); __builtin_amdgcn_s_setprio(0); } while (0)
#define PG8_WAIT_V(n) asm volatile("s_waitcnt vmcnt(" #n ")" ::: "memory")
#define PG8_WAIT_L(n) asm volatile("s_waitcnt lgkmcnt(" #n ")" ::: "memory")
#define PG8_BAR __builtin_amdgcn_s_barrier()
#define PG8_SCHED __builtin_amdgcn_sched_barrier(0)
    Unit cur, nxt; int ui = 0;
    if (!S.next(0, cur)) return;
    cur.ord = 0;
    f32x4 acc[2][2][4][2];
#pragma unroll
    for (int a = 0; a < 2; ++a)
#pragma unroll
        for (int b = 0; b < 2; ++b)
#pragma unroll
            for (int m = 0; m < 4; ++m)
#pragma unroll
                for (int n = 0; n < 2; ++n) acc[a][b][m][n] = (f32x4){0.f, 0.f, 0.f, 0.f};
    bf16x8 At[4][2], B0[2][2], B1[2][2];
    const GAS char* cA = (const GAS char*)g.A + (size_t)cur.pm * tA + (size_t)(cur.pn >> g.a_shift) * g.a_stride;
    const GAS char* cB = (const GAS char*)g.Bt + (size_t)cur.pn * tB;
    PG8_STAGE(PG8_SB(0, 0), cB, voffB); PG8_STAGE(PG8_SB(0, 1), cB + hB, voffB); PG8_STAGE(PG8_SA(0, 0), cA, voffA); PG8_STAGE(PG8_SA(0, 1), cA + hA, voffA);
    pre();
    if (wr == 1) PG8_BAR;
    PG8_WAIT_V(2); PG8_BAR;
    PG8_STAGE(PG8_SB(1, 0), cB + kstep, voffB); PG8_STAGE(PG8_SA(1, 0), cA + kstep, voffA); PG8_STAGE(PG8_SB(1, 1), cB + hB + kstep, voffB);
    PG8_WAIT_V(6); PG8_BAR;
    for (;;) {
        const bool has_next = S.next(ui + 1, nxt); nxt.ord = ui + 1;
        const GAS char* nA = has_next ? (const GAS char*)g.A + (size_t)nxt.pm * tA + (size_t)(nxt.pn >> g.a_shift) * g.a_stride : cA;
        const GAS char* nB = has_next ? (const GAS char*)g.Bt + (size_t)nxt.pn * tB : cB;
        for (int t = 0; t < nt; t += 2) {
            const bool last = (t == nt - 2);
            const GAS char* a1 = cA + (size_t)(t + 1) * kstep;
            const GAS char* a2 = last ? nA : cA + (size_t)(t + 2) * kstep; const GAS char* b2 = last ? nB : cB + (size_t)(t + 2) * kstep;
            const GAS char* a3 = a2 + kstep; const GAS char* b3 = b2 + kstep;
            PG8_LDB(B0, 0, 0); if constexpr (!HALFN) PG8_LDB(B1, 0, 1); PG8_SCHED; PG8_LDA(At, 0, 0); PG8_STAGE(PG8_SA(1, 1), a1 + hA, voffA);
            PG8_WAIT_V(8); PG8_WAIT_L(0); PG8_BAR; PG8_MMA(0, 0, At, B0); if constexpr (!HALFN) PG8_MMA(0, 1, At, B1); PG8_BAR; PG8_SCHED;
            PG8_LDA(At, 0, 1); PG8_STAGE(PG8_SB(0, 0), b2, voffB); PG8_STAGE(PG8_SB(0, 1), b2 + hB, voffB); PG8_STAGE(PG8_SA(0, 0), a2, voffA);
            PG8_WAIT_V(8); PG8_WAIT_L(0); PG8_BAR; PG8_MMA(1, 0, At, B0); if constexpr (!HALFN) PG8_MMA(1, 1, At, B1); PG8_BAR; PG8_SCHED;
            PG8_LDB(B0, 1, 0); if constexpr (!HALFN) PG8_LDB(B1, 1, 1); PG8_SCHED; PG8_LDA(At, 1, 0); PG8_STAGE(PG8_SA(0, 1), a2 + hA, voffA);
            PG8_WAIT_V(8); PG8_WAIT_L(0); PG8_BAR; PG8_MMA(0, 0, At, B0); if constexpr (!HALFN) PG8_MMA(0, 1, At, B1); PG8_BAR; PG8_SCHED;
            PG8_LDA(At, 1, 1); PG8_STAGE(PG8_SB(1, 0), b3, voffB); PG8_STAGE(PG8_SB(1, 1), b3 + hB, voffB); PG8_STAGE(PG8_SA(1, 0), a3, voffA);
            PG8_WAIT_V(8); PG8_WAIT_L(0); PG8_BAR; PG8_MMA(1, 0, At, B0); if constexpr (!HALFN) PG8_MMA(1, 1, At, B1); PG8_BAR; PG8_SCHED;
        }
        if (wr == 0) PG8_BAR;
        E(acc, cur, wr, wc, fr, fq);
        if (!has_next) break;
#pragma unroll
        for (int a = 0; a < 2; ++a)
#pragma unroll
            for (int b = 0; b < 2; ++b)
#pragma unroll
                for (int m = 0; m < 4; ++m)
#pragma unroll
                    for (int n = 0; n < 2; ++n) acc[a][b][m][n] = (f32x4){0.f, 0.f, 0.f, 0.f};
        cur = nxt; cA = nA; cB = nB; ++ui;
        if (wr == 1) PG8_BAR;
    }
    PG8_WAIT_V(0);
    PG8_BAR;
#undef PG8_SA
#undef PG8_SB
#undef PG8_STAGE
#undef PG8_LDA
#undef PG8_LDB
#undef PG8_MMA
#undef PG8_WAIT_V
#undef PG8_WAIT_L
#undef PG8_BAR
#undef PG8_SCHED
}
}

__device__ __forceinline__ void norm_pass(const float* xin, float* xout, const float* y, const float* part, float wgt, const float* g_post, const float* g_pre, bf16_t* h,
                                          int nrows, int gw, int ngw, int lane) {
    for (int row = gw; row < nrows; row += ngw) {
        const GAS f32x4* xr = (const GAS f32x4*)(xin + (size_t)row * DM) + lane;
        f32x4 v[8];
#pragma unroll
        for (int j = 0; j < 8; ++j) v[j] = xr[64 * j];
        if (y) {
            const float ps = (lane < 32) ? ((const GAS float*)part)[(size_t)lane * MTOK + row] : 0.f;
            const float ss = wave_sum(ps);
            const float r = wgt * rsqrtf(ss * (1.0f / DM) + EPS);
            const GAS f32x4* yr = (const GAS f32x4*)(y + (size_t)row * DM) + lane; const GAS f32x4* gp = (const GAS f32x4*)g_post + lane;
#pragma unroll
            for (int j = 0; j < 8; ++j) v[j] += yr[64 * j] * gp[64 * j] * r;
        }
        if (xout) { GAS f32x4* xo = (GAS f32x4*)(xout + (size_t)row * DM) + lane;
#pragma unroll
            for (int j = 0; j < 8; ++j) xo[64 * j] = v[j]; }
        if (h) {
            float s2 = 0.f;
#pragma unroll
            for (int j = 0; j < 8; ++j) s2 += (v[j][0] * v[j][0] + v[j][1] * v[j][1]) + (v[j][2] * v[j][2] + v[j][3] * v[j][3]);
            s2 = wave_sum(s2);
            const float r2 = rsqrtf(s2 * (1.0f / DM) + EPS);
            const GAS f32x4* gq = (const GAS f32x4*)g_pre + lane; GAS u32x2* ho = (GAS u32x2*)(h + (size_t)row * DM) + lane;
#pragma unroll
            for (int j = 0; j < 8; ++j) { const f32x4 o = v[j] * gq[64 * j] * r2; u32x2 w; w.x = cvt_pk_bf16(o[0], o[1]); w.y = cvt_pk_bf16(o[2], o[3]); ho[64 * j] = w; }
        }
    }
}

__device__ __forceinline__ void prep_pass(const float* xin, bf16_t* xb, float* rs, int nrows, int gw, int ngw, int lane) {
    for (int row = gw; row < nrows; row += ngw) {
        const GAS f32x4* xr = (const GAS f32x4*)(xin + (size_t)row * DM) + lane;
        f32x4 v[8];
#pragma unroll
        for (int j = 0; j < 8; ++j) v[j] = xr[64 * j];
        float s2 = 0.f;
#pragma unroll
        for (int j = 0; j < 8; ++j) s2 += (v[j][0] * v[j][0] + v[j][1] * v[j][1]) + (v[j][2] * v[j][2] + v[j][3] * v[j][3]);
        s2 = wave_sum(s2);
        GAS u32x2* ho = (GAS u32x2*)(xb + (size_t)row * DM) + lane;
#pragma unroll
        for (int j = 0; j < 8; ++j) { u32x2 w; w.x = cvt_pk_bf16(v[j][0], v[j][1]); w.y = cvt_pk_bf16(v[j][2], v[j][3]); ho[64 * j] = w; }
        if (lane < 8) ((GAS float*)rs)[(size_t)row * 8 + lane] = (lane == 0) ? s2 : 0.f;
    }
}

__device__ __forceinline__ void rope_rot(const u32x4 x1, const u32x4 x2, const f32x2* tb, u32x4& r1, u32x4& r2) {
    const GAS f32x4* t = (const GAS f32x4*)tb;
#pragma unroll
    for (int p = 0; p < 4; ++p) {
        const f32x4 cc = t[p]; const f32x2 c0 = {cc[0], cc[1]}, c1 = {cc[2], cc[3]};
        const float a0 = bflo(x1[p]), a1 = bfhi(x1[p]), b0 = bflo(x2[p]), b1 = bfhi(x2[p]);
        r1[p] = cvt_pk_bf16(a0 * c0.x - b0 * c0.y, a1 * c1.x - b1 * c1.y);
        r2[p] = cvt_pk_bf16(b0 * c0.x + a0 * c0.y, b1 * c1.x + a1 * c1.y);
    }
}

__device__ __forceinline__ void rope_rot_t(const u32x4 x1, const u32x4 x2, const f32x4 (&cc)[4], u32x4& r1, u32x4& r2) {
#pragma unroll
    for (int p = 0; p < 4; ++p) {
        const f32x2 c0 = {cc[p][0], cc[p][1]}, c1 = {cc[p][2], cc[p][3]};
        const float a0 = bflo(x1[p]), a1 = bfhi(x1[p]), b0 = bflo(x2[p]), b1 = bfhi(x2[p]);
        r1[p] = cvt_pk_bf16(a0 * c0.x - b0 * c0.y, a1 * c1.x - b1 * c1.y);
        r2[p] = cvt_pk_bf16(b0 * c0.x + a0 * c0.y, b1 * c1.x + a1 * c1.y);
    }
}
constexpr int SA_KLD = 72, SA_VLD = 280;
__device__ __forceinline__ void attn_unit(LAS unsigned char* lds, const bf16_t* z, bf16_t* cat, const f32x2* rope, const float* sinks, int unit, int tid, int wid, int lane) {
    const int kvh = unit & 1, blk = (unit >> 1) & 31, b = unit >> 6;
    const int tokq = b * SEQ + blk * 128, tokk = tokq - 128;
    LAS bf16_t* Ks = (LAS bf16_t*)lds;
    LAS bf16_t* Vt = (LAS bf16_t*)(lds + 256 * SA_KLD * 2);
    const GAS bf16_t* zg = (const GAS bf16_t*)z;
    {
        u32x4 kva[4], vva[4], x1a[4], x2a[4]; f32x4 tba[4][4];
#pragma unroll
        for (int c = 0; c < 4; ++c) {
            const int idx = tid + 512 * c, key = idx >> 3, ch = idx & 7;
            const int pos = blk * 128 - 128 + key; const bool okp = pos >= 0;
            const GAS bf16_t* zr = zg + (size_t)(okp ? tokk + key : tokq) * INW;
            kva[c] = *(const GAS u32x4*)(zr + 1024 + kvh * 64 + ch * 8);
            vva[c] = *(const GAS u32x4*)(zr + 1152 + kvh * 64 + ch * 8);
            x1a[c] = *(const GAS u32x4*)(zr + 1024 + kvh * 64); x2a[c] = *(const GAS u32x4*)(zr + 1024 + kvh * 64 + 8);
            const GAS f32x4* tp = (const GAS f32x4*)(rope + (size_t)(okp ? pos : 0) * 8);
#pragma unroll
            for (int p = 0; p < 4; ++p) tba[c][p] = tp[p];
        }
        asm volatile("" ::: "memory");
#pragma unroll
        for (int c = 0; c < 4; ++c) {
            const int idx = tid + 512 * c, key = idx >> 3, ch = idx & 7;
            const bool okp = (blk * 128 - 128 + key) >= 0;
            u32x4 r1, r2; rope_rot_t(x1a[c], x2a[c], tba[c], r1, r2);
            u32x4 kv = ch == 0 ? r1 : (ch == 1 ? r2 : kva[c]), vv = vva[c];
            if (!okp) { kv = (u32x4){0u, 0u, 0u, 0u}; vv = (u32x4){0u, 0u, 0u, 0u}; }
            *(LAS u32x4*)(Ks + key * SA_KLD + ch * 8) = kv;
#pragma unroll
            for (int p = 0; p < 4; ++p) { Vt[(ch * 8 + 2 * p) * SA_VLD + key] = (bf16_t)(vv[p] & 0xffffu); Vt[(ch * 8 + 2 * p + 1) * SA_VLD + key] = (bf16_t)(vv[p] >> 16); }
        }
    }
    for (int idx = tid; idx < 64 * 24; idx += 512) Vt[(idx / 24) * SA_VLD + 256 + (idx % 24)] = 0;
    __syncthreads();
    const int hq = kvh * 8 + wid; const float sink = ((const GAS float*)sinks)[hq];
    const int qi = lane & 15, g = lane >> 4;
    for (int qs = 0; qs < 8; ++qs) {
        const int row = tokq + 16 * qs + qi, pos = blk * 128 + 16 * qs + qi;
        const GAS bf16_t* zr = zg + (size_t)row * INW + hq * 64;
        bf16x8 qf0, qf1;
        { const u32x4 x1 = *(const GAS u32x4*)(zr), x2 = *(const GAS u32x4*)(zr + 8); u32x4 r1, r2; rope_rot(x1, x2, rope + (size_t)pos * 8, r1, r2);
          const u32x4 own = *(const GAS u32x4*)(zr + 8 * g);
          const u32x4 sel = g == 0 ? r1 : (g == 1 ? r2 : own); qf0 = __builtin_bit_cast(bf16x8, sel); }
        qf1 = __builtin_bit_cast(bf16x8, *(const GAS u32x4*)(zr + 32 + 8 * g));
        f32x4 s[9];
#pragma unroll
        for (int t = 0; t < 9; ++t) {
            const LAS bf16_t* kp = Ks + (16 * (qs + t) + qi) * SA_KLD + 8 * g;
            const bf16x8 a0 = *(const LAS bf16x8*)kp, a1 = *(const LAS bf16x8*)(kp + 32);
            f32x4 acc = (f32x4){0.f, 0.f, 0.f, 0.f};
            acc = MFMA16(a0, qf0, acc); acc = MFMA16(a1, qf1, acc); s[t] = acc;
            if ((t % 3) == 2) __builtin_amdgcn_sched_barrier(0);
        }
        float mx = sink;
        const int i = 16 * qs + qi;
#pragma unroll
        for (int t = 0; t < 9; ++t)
#pragma unroll
            for (int r = 0; r < 4; ++r) {
                const int j = 16 * (qs + t) + 4 * g + r;
                const bool valid = (j > i) && (j <= i + 128) && (blk > 0 || j >= 128);
                const float v = valid ? s[t][r] * 0.125f : -1e30f; s[t][r] = v; mx = fmaxf(mx, v);
            }
        mx = fmaxf(mx, __shfl_xor(mx, 16)); mx = fmaxf(mx, __shfl_xor(mx, 32));
        float l = 0.f;
#pragma unroll
        for (int t = 0; t < 9; ++t)
#pragma unroll
            for (int r = 0; r < 4; ++r) { const float e = __expf(s[t][r] - mx); s[t][r] = e; l += e; }
        l += __shfl_xor(l, 16); l += __shfl_xor(l, 32); l += __expf(sink - mx);
        const float inv = 1.0f / l;
        bf16x8 pf[5];
#pragma unroll
        for (int s5 = 0; s5 < 5; ++s5) {
            u32x4 w; w.x = cvt_pk_bf16(s[2 * s5][0], s[2 * s5][1]); w.y = cvt_pk_bf16(s[2 * s5][2], s[2 * s5][3]);
            if (2 * s5 + 1 < 9) { w.z = cvt_pk_bf16(s[(2 * s5 + 1) % 9][0], s[(2 * s5 + 1) % 9][1]); w.w = cvt_pk_bf16(s[(2 * s5 + 1) % 9][2], s[(2 * s5 + 1) % 9][3]); } else { w.z = 0u; w.w = 0u; }
            pf[s5] = __builtin_bit_cast(bf16x8, w);
        }
#pragma unroll
        for (int dt = 0; dt < 4; ++dt) {
            f32x4 acc = (f32x4){0.f, 0.f, 0.f, 0.f};
#pragma unroll
            for (int s5 = 0; s5 < 5; ++s5) {
                const LAS bf16_t* vp = Vt + (16 * dt + qi) * SA_VLD + 16 * (qs + 2 * s5) + 4 * g;
                const s16x4 lo = *(const LAS s16x4*)vp, hi = *(const LAS s16x4*)(vp + 16);
                const bf16x8 a = __builtin_shufflevector(lo, hi, 0, 1, 2, 3, 4, 5, 6, 7);
                acc = MFMA16(a, pf[s5], acc);
            }
            u32x2 w; w.x = cvt_pk_bf16(acc[0] * inv, acc[1] * inv); w.y = cvt_pk_bf16(acc[2] * inv, acc[3] * inv);
            *(GAS u32x2*)((GAS bf16_t*)cat + (size_t)row * DM + hq * 64 + 16 * dt + 4 * g) = w;
            __builtin_amdgcn_sched_barrier(0);
        }
    }
    __syncthreads();
}

constexpr int SG_LD = 136;
__device__ __forceinline__ void sgu_unit(LAS unsigned char* lds, const bf16_t* z, bf16_t* cat, const f32x2* sst, const bf16_t* wsgu, const float* ln_g, const float* ln_b, const float* b_s,
                                         int unit, int tid, int wid, int lane) {
    const int grp = unit & 7, chunk = (unit >> 3) & 31, b = unit >> 8;
    const int tb = b * SEQ + chunk * 128;
    LAS bf16_t* Vt = (LAS bf16_t*)lds;
    LAS bf16_t* Wl = (LAS bf16_t*)(lds + 128 * SG_LD * 2);
    LAS float* mu = (LAS float*)(lds + 2 * 128 * SG_LD * 2); LAS float* rs = mu + 128;
    const GAS bf16_t* zg = (const GAS bf16_t*)z;
    if (tid < 128) {
        float s1 = 0.f, s2 = 0.f;
#pragma unroll
        for (int p = 0; p < 16; ++p) { const f32x2 v = ((const GAS f32x2*)sst)[(size_t)p * MTOK + tb + tid]; s1 += v.x; s2 += v.y; }
        const float m = s1 * (1.0f / 1024.0f); const float var = fmaxf(s2 * (1.0f / 1024.0f) - m * m, 0.f);
        mu[tid] = m; rs[tid] = rsqrtf(var + EPS);
    }
    __syncthreads();
    {
        const int ch = tid & 15;
        u32x4 vva[4], wwa[4];
#pragma unroll
        for (int c = 0; c < 4; ++c) {
            const int idx = tid + 512 * c, j = idx >> 4;
            vva[c] = *(const GAS u32x4*)(zg + (size_t)(tb + j) * INW + 2304 + grp * 128 + ch * 8);
            wwa[c] = *(const GAS u32x4*)((const GAS bf16_t*)wsgu + (size_t)grp * 16384 + j * 128 + ch * 8);
        }
        const GAS float* lg = (const GAS float*)ln_g + grp * 128 + ch * 8; const GAS float* lb = (const GAS float*)ln_b + grp * 128 + ch * 8;
        const f32x4 lg0 = *(const GAS f32x4*)lg, lg1 = *(const GAS f32x4*)(lg + 4), lb0 = *(const GAS f32x4*)lb, lb1 = *(const GAS f32x4*)(lb + 4);
        const float lgv[8] = {lg0[0], lg0[1], lg0[2], lg0[3], lg1[0], lg1[1], lg1[2], lg1[3]}, lbv[8] = {lb0[0], lb0[1], lb0[2], lb0[3], lb1[0], lb1[1], lb1[2], lb1[3]};
        asm volatile("" ::: "memory");
#pragma unroll
        for (int c = 0; c < 4; ++c) {
            const int idx = tid + 512 * c, j = idx >> 4;
            const float m = mu[j], r = rs[j];
#pragma unroll
            for (int p = 0; p < 4; ++p) {
                const float v0 = (bflo(vva[c][p]) - m) * r * lgv[2 * p] + lbv[2 * p], v1 = (bfhi(vva[c][p]) - m) * r * lgv[2 * p + 1] + lbv[2 * p + 1];
                const unsigned w = cvt_pk_bf16(v0, v1);
                Vt[(ch * 8 + 2 * p) * SG_LD + j] = (bf16_t)(w & 0xffffu); Vt[(ch * 8 + 2 * p + 1) * SG_LD + j] = (bf16_t)(w >> 16);
            }
            *(LAS u32x4*)(Wl + j * SG_LD + ch * 8) = wwa[c];
        }
    }
    __syncthreads();
    const int li = lane & 15, g = lane >> 4;
    u32x2 uuv[8]; float biasv[8];
#pragma unroll
    for (int it = 0; it < 8; ++it) {
        uuv[it] = *(const GAS u32x2*)(zg + (size_t)(tb + 16 * it + li) * INW + 1280 + grp * 128 + 16 * wid + 4 * g);
        biasv[it] = ((const GAS float*)b_s)[grp * 128 + 16 * it + li];
    }
#pragma unroll
    for (int it = 0; it < 8; ++it) {
        f32x4 acc = (f32x4){0.f, 0.f, 0.f, 0.f};
#pragma unroll
        for (int ks = 0; ks < 4; ++ks) {
            if (32 * ks <= 16 * it + 15) {
                const bf16x8 a = *(const LAS bf16x8*)(Vt + (16 * wid + li) * SG_LD + 32 * ks + 8 * g);
                const bf16x8 bb = *(const LAS bf16x8*)(Wl + (16 * it + li) * SG_LD + 32 * ks + 8 * g);
                acc = MFMA16(a, bb, acc);
            }
        }
        const int tok = tb + 16 * it + li; const int c0 = grp * 128 + 16 * wid + 4 * g;
        const float bias = biasv[it];
        const u32x2 uu = uuv[it];
        u32x2 w; w.x = cvt_pk_bf16(bflo(uu.x) * (acc[0] + bias), bfhi(uu.x) * (acc[1] + bias)); w.y = cvt_pk_bf16(bflo(uu.y) * (acc[2] + bias), bfhi(uu.y) * (acc[3] + bias));
        *(GAS u32x2*)((GAS bf16_t*)cat + (size_t)tok * DM + 1024 + c0) = w;
    }
    __syncthreads();
}

constexpr int XA_KLD = 136, XA_VLD = 264;
__device__ __forceinline__ void xattn_unit(LAS unsigned char* lds, const bf16_t* q, const bf16_t* kv, bf16_t* o, int unit, int tid, int wid, int lane) {
    const int qb = unit & 15, head = (unit >> 4) & 3, b = unit >> 6;
    LAS bf16_t* Kc = (LAS bf16_t*)lds;
    LAS bf16_t* Vt = (LAS bf16_t*)(lds + 256 * XA_KLD * 2);
    const GAS bf16_t* kvg = (const GAS bf16_t*)kv;
    {
        u32x4 kka[8], vva[8];
#pragma unroll
        for (int c = 0; c < 8; ++c) {
            const int idx = tid + 512 * c, key = idx >> 4, ch = idx & 15;
            const GAS bf16_t* kr = kvg + (size_t)(b * 256 + key) * 1024 + head * 128 + ch * 8;
            kka[c] = *(const GAS u32x4*)kr; vva[c] = *(const GAS u32x4*)(kr + 512);
        }
        asm volatile("" ::: "memory");
#pragma unroll
        for (int c = 0; c < 8; ++c) {
            const int idx = tid + 512 * c, key = idx >> 4, ch = idx & 15;
            *(LAS u32x4*)(Kc + key * XA_KLD + ch * 8) = kka[c];
#pragma unroll
            for (int p = 0; p < 4; ++p) { Vt[(ch * 8 + 2 * p) * XA_VLD + key] = (bf16_t)(vva[c][p] & 0xffffu); Vt[(ch * 8 + 2 * p + 1) * XA_VLD + key] = (bf16_t)(vva[c][p] >> 16); }
        }
    }
    __syncthreads();
    const int qi = lane & 15, g = lane >> 4;
    for (int sb = 0; sb < 2; ++sb) {
        const int row = b * SEQ + qb * 256 + wid * 32 + sb * 16 + qi;
        const GAS bf16_t* qr = (const GAS bf16_t*)q + (size_t)row * 512 + head * 128 + 8 * g;
        bf16x8 qf[4];
#pragma unroll
        for (int ks = 0; ks < 4; ++ks) qf[ks] = __builtin_bit_cast(bf16x8, *(const GAS u32x4*)(qr + 32 * ks));
        f32x4 s[16];
#pragma unroll
        for (int kt = 0; kt < 16; ++kt) {
            f32x4 acc = (f32x4){0.f, 0.f, 0.f, 0.f};
#pragma unroll
            for (int ks = 0; ks < 4; ++ks) { const bf16x8 a = *(const LAS bf16x8*)(Kc + (16 * kt + qi) * XA_KLD + 32 * ks + 8 * g); acc = MFMA16(a, qf[ks], acc); }
            s[kt] = acc * 0.08838834764831845f;
            if (kt & 1) __builtin_amdgcn_sched_barrier(0);
        }
        float mx = -1e30f;
#pragma unroll
        for (int kt = 0; kt < 16; ++kt) mx = fmaxf(fmaxf(mx, fmaxf(s[kt][0], s[kt][1])), fmaxf(s[kt][2], s[kt][3]));
        mx = fmaxf(mx, __shfl_xor(mx, 16)); mx = fmaxf(mx, __shfl_xor(mx, 32));
        float l = 0.f;
#pragma unroll
        for (int kt = 0; kt < 16; ++kt)
#pragma unroll
            for (int r = 0; r < 4; ++r) { const float e = __expf(s[kt][r] - mx); s[kt][r] = e; l += e; }
        l += __shfl_xor(l, 16); l += __shfl_xor(l, 32);
        const float inv = 1.0f / l;
        bf16x8 pf[8];
#pragma unroll
        for (int s8 = 0; s8 < 8; ++s8) {
            u32x4 w; w.x = cvt_pk_bf16(s[2 * s8][0], s[2 * s8][1]); w.y = cvt_pk_bf16(s[2 * s8][2], s[2 * s8][3]);
            w.z = cvt_pk_bf16(s[2 * s8 + 1][0], s[2 * s8 + 1][1]); w.w = cvt_pk_bf16(s[2 * s8 + 1][2], s[2 * s8 + 1][3]);
            pf[s8] = __builtin_bit_cast(bf16x8, w);
        }
#pragma unroll
        for (int dt = 0; dt < 8; ++dt) {
            f32x4 acc = (f32x4){0.f, 0.f, 0.f, 0.f};
#pragma unroll
            for (int s8 = 0; s8 < 8; ++s8) {
                const LAS bf16_t* vp = Vt + (16 * dt + qi) * XA_VLD + 32 * s8 + 4 * g;
                const s16x4 lo = *(const LAS s16x4*)vp, hi = *(const LAS s16x4*)(vp + 16);
                const bf16x8 a = __builtin_shufflevector(lo, hi, 0, 1, 2, 3, 4, 5, 6, 7);
                acc = MFMA16(a, pf[s8], acc);
            }
            u32x2 w; w.x = cvt_pk_bf16(acc[0] * inv, acc[1] * inv); w.y = cvt_pk_bf16(acc[2] * inv, acc[3] * inv);
            *(GAS u32x2*)((GAS bf16_t*)o + (size_t)row * 512 + head * 128 + 16 * dt + 4 * g) = w;
            __builtin_amdgcn_sched_barrier(0);
        }
    }
    __syncthreads();
}

template <int W>
__device__ __forceinline__ void pool_body(const LAS float* R, const GAS bf16_t* hg, const f32x4 gv, GAS bf16_t* pg, int t0, int s0) {
    constexpr int NR = W - 1 + 32;
    u32x2 v[NR];
#pragma unroll
    for (int k = 0; k < NR; ++k) { const int tok = t0 - (W - 1) + k; v[k] = *(const GAS u32x2*)(hg + (size_t)(tok < 0 ? 0 : tok) * DM); }
    f32x4 sum = (f32x4){0.f, 0.f, 0.f, 0.f};
#pragma unroll
    for (int k = 0; k < W - 1; ++k) { const float r = R[16 - W + k]; sum += (f32x4){bflo(v[k].x), bfhi(v[k].x), bflo(v[k].y), bfhi(v[k].y)} * r; }
#pragma unroll
    for (int i = 0; i < 32; ++i) {
        const float r = R[15 + i];
        const f32x4 cur = (f32x4){bflo(v[W - 1 + i].x), bfhi(v[W - 1 + i].x), bflo(v[W - 1 + i].y), bfhi(v[W - 1 + i].y)} * r;
        const int cnt = (s0 + i + 1) < W ? (s0 + i + 1) : W;
        const float ic = 1.0f / (float)cnt;
        sum += cur;
        const f32x4 o = (sum * ic - cur) * gv;
        u32x2 wv; wv.x = cvt_pk_bf16(o[0], o[1]); wv.y = cvt_pk_bf16(o[2], o[3]);
        *(GAS u32x2*)(pg + (size_t)(t0 + i) * DM) = wv;
        const float ro = R[15 + i - (W - 1)];
        sum -= (f32x4){bflo(v[i].x), bfhi(v[i].x), bflo(v[i].y), bfhi(v[i].y)} * ro;
    }
}
__device__ __forceinline__ void pool_unit(LAS unsigned char* lds, const bf16_t* xb, const float* rs, const float* gpre, bf16_t* pooled, int unit, int tid) {
    LAS float* R = (LAS float*)lds;
    const int t0 = unit * 32, s0 = t0 & (SEQ - 1);
    if (tid < 47) { const int tok = t0 - 15 + tid; R[tid] = ((s0 - 15 + tid) >= 0) ? row_rs(rs, tok) : 0.f; }
    __syncthreads();
    const int c0 = tid * 4;
    const GAS bf16_t* hg = (const GAS bf16_t*)xb + c0; GAS bf16_t* pg = (GAS bf16_t*)pooled + c0;
    const f32x4 gv = *(const GAS f32x4*)((const GAS float*)gpre + c0);
    const int grp = __builtin_amdgcn_readfirstlane(c0 >> 9);
    if (grp == 0) pool_body<2>(R, hg, gv, pg, t0, s0);
    else if (grp == 1) pool_body<4>(R, hg, gv, pg, t0, s0);
    else if (grp == 2) pool_body<8>(R, hg, gv, pg, t0, s0);
    else pool_body<16>(R, hg, gv, pg, t0, s0);
    __syncthreads();
}

#define XB_TMO      128
#define XB_XCNT(j)  (256  + 64 * (j))
#define XB_XSUB(j)  (1280 + 64 * (j))
#define XB_XGEN(j)  (2304 + 64 * (j))
#define XB_TOP      3328
#define XB_TOPGEN   3392
#define XCD_BAR_WORDS 3456
#define XB_SPIN_CAP (1u << 22)
__device__ __forceinline__ unsigned xb_ld(unsigned* p)              { return __hip_atomic_load(p, __ATOMIC_RELAXED, __HIP_MEMORY_SCOPE_AGENT); }
__device__ __forceinline__ unsigned xb_add(unsigned* p, unsigned v) { return __hip_atomic_fetch_add(p, v, __ATOMIC_RELAXED, __HIP_MEMORY_SCOPE_AGENT); }
__device__ __forceinline__ unsigned xb_xcc_id() { return (unsigned)__builtin_amdgcn_s_getreg((3 << 11) | 20) & 0xFu; }
#define XB_SPIN(cond, bar) do { unsigned _sp = 0; while (cond) { __builtin_amdgcn_s_sleep(1); \
    if ((++_sp & 255u) == 0u) { if (xb_ld(&(bar)[XB_TMO])) break; if (_sp > XB_SPIN_CAP) { atomicAdd(&(bar)[XB_TMO], 1u); break; } } } } while (0)
struct XcdBarrier { unsigned* bar; unsigned x; volatile LAS unsigned* st; };
__device__ __forceinline__ XcdBarrier xcd_barrier_post(unsigned* bar, volatile LAS unsigned* st) {
    XcdBarrier b; b.bar = bar; b.x = xb_xcc_id(); b.st = st;
    if (threadIdx.x == 0) (void)xb_add(&bar[XB_XCNT(b.x)], 1u);
    return b;
}
__device__ __forceinline__ void xcd_barrier_complete(unsigned* bar, unsigned x, unsigned& nloc, unsigned& nx) {
    const unsigned G = gridDim.x * gridDim.y * gridDim.z;
    unsigned sum, cnt, mine, sp = 0u;
    for (;;) {
        sum = 0u; cnt = 0u; mine = 0u;
#pragma unroll
        for (unsigned j = 0; j < 16; ++j) { const unsigned c = xb_ld(&bar[XB_XCNT(j)]); sum += c; cnt += (c > 0u) ? 1u : 0u; mine = (j == x) ? c : mine; }
        if (sum == G) break;
        __builtin_amdgcn_s_sleep(1);
        if ((++sp & 255u) == 0u) { if (xb_ld(&bar[XB_TMO])) break; if (sp > XB_SPIN_CAP) { atomicAdd(&bar[XB_TMO], 1u); break; } }
    }
    nloc = mine > 0u ? mine : 1u; nx = cnt > 0u ? cnt : 1u;
}
__device__ __forceinline__ void xcd_barrier(const XcdBarrier& b) {
    asm volatile("s_waitcnt vmcnt(0)" ::: "memory");
    __syncthreads();
    if (threadIdx.x == 0) {
        unsigned* bar = b.bar;
        __builtin_amdgcn_s_waitcnt(0);
        unsigned nloc = b.st[0], nx = b.st[1];
        if (nloc == 0u) { xcd_barrier_complete(bar, b.x, nloc, nx); b.st[0] = nloc; b.st[1] = nx; }
        const unsigned old = xb_add(&bar[XB_XSUB(b.x)], 1u);
        const unsigned gen = old / nloc;
        if (old + 1u == (gen + 1u) * nloc) {
            __builtin_amdgcn_fence(__ATOMIC_RELEASE, "agent");
            asm volatile("s_waitcnt vmcnt(0)" ::: "memory");
            const unsigned og = xb_add(&bar[XB_TOP], 1u);
            const unsigned tg = og / nx;
            if (og + 1u == (tg + 1u) * nx) xb_add(&bar[XB_TOPGEN], 1u);
            else XB_SPIN(xb_ld(&bar[XB_TOPGEN]) == tg, bar);
            __builtin_amdgcn_fence(__ATOMIC_ACQUIRE, "agent");
            xb_add(&bar[XB_XGEN(b.x)], 1u);
            asm volatile("s_waitcnt vmcnt(0)" ::: "memory");
        } else {
            XB_SPIN(xb_ld(&bar[XB_XGEN(b.x)]) == gen, bar);
            __builtin_amdgcn_fence(__ATOMIC_ACQUIRE, "agent");
            asm volatile("s_waitcnt vmcnt(0)" ::: "memory");
        }
    }
    __syncthreads();
}

template <class Sched>
__device__ __forceinline__ void fill_rs_table(LAS float* T, const float* rsp, const Sched& S, int tid) {
    const int half = __builtin_amdgcn_readfirstlane(tid >> 8), lt = tid & 255;
    f32x4 a[8], b[8]; bool ok[8];
#pragma unroll
    for (int j = 0; j < 8; ++j) {
        pg8::Unit u; const int i = 2 * j + half;
        ok[j] = (i < RS_TABLE_UNITS) && S.next(i, u);
        const int pm = ok[j] ? u.pm : 0;
        const GAS float* p = (const GAS float*)rsp + ((size_t)pm * 256 + lt) * 8;
        a[j] = *(const GAS f32x4*)p; b[j] = *(const GAS f32x4*)(p + 4);
    }
#pragma unroll
    for (int j = 0; j < 8; ++j)
        if (ok[j]) T[(2 * j + half) * 256 + lt] = __builtin_amdgcn_rsqf((((a[j][0] + a[j][1]) + (a[j][2] + a[j][3])) + ((b[j][0] + b[j][1]) + (b[j][2] + b[j][3]))) * (1.0f / DM) + EPS);
    __syncthreads();
}

struct Args { const float* in[23]; float* out; unsigned char* ws; float inv[8]; int ph_lo, ph_hi; };

struct ConvJob { const float* W; bf16_t* WT; const float* scale; const float* kscale; int K, N, mode, roff, item; };
constexpr int CI_FF = (DM / 64) * (DFF / 32), CI_Q = (DM / 64) * (512 / 32), CI_WO = (512 / 64) * (DM / 32), CI_IN = (DM / 64) * (INW / 32), CI_OUT = (DM / 64) * (DM / 32), CI_PL = (512 / 64) * (512 / 32);
constexpr int CI_COMMON = 6 * CI_FF + 3 * CI_Q + CI_WO, CI_L0 = CI_COMMON + CI_IN + CI_OUT, CI_L1 = CI_COMMON + 4 * CI_PL;
__device__ __forceinline__ ConvJob conv_decode(const Args& a, int r) {
    int layer = 0; if (r >= CI_L0) { layer = 1; r -= CI_L0; }
    unsigned char* ws = a.ws + WS_WL + (size_t)layer * WL_STRIDE;
    const size_t FW = (size_t)DM * DFF;
    const float* nb = a.in[2] + (size_t)layer * 8 * DM;
    ConvJob j; j.scale = nullptr; j.kscale = nullptr; j.mode = 0; j.roff = 0; j.K = DM; j.N = DFF;
    if (r < CI_FF) { j.W = a.in[4] + layer * FW; j.WT = (bf16_t*)(ws + WO_W1A); j.mode = 1; j.kscale = nb; j.item = r; return j; } r -= CI_FF;
    if (r < CI_FF) { j.W = a.in[5] + layer * FW; j.WT = (bf16_t*)(ws + WO_W1A); j.mode = 2; j.kscale = nb; j.item = r; return j; } r -= CI_FF;
    if (r < CI_FF) { j.W = a.in[6] + layer * FW; j.WT = (bf16_t*)(ws + WO_W1D); j.K = DFF; j.N = DM; j.item = r; return j; } r -= CI_FF;
    if (r < CI_FF) { j.W = a.in[7] + layer * FW; j.WT = (bf16_t*)(ws + WO_W2A); j.mode = 1; j.kscale = nb + 6 * DM; j.item = r; return j; } r -= CI_FF;
    if (r < CI_FF) { j.W = a.in[8] + layer * FW; j.WT = (bf16_t*)(ws + WO_W2A); j.mode = 2; j.kscale = nb + 6 * DM; j.item = r; return j; } r -= CI_FF;
    if (r < CI_FF) { j.W = a.in[9] + layer * FW; j.WT = (bf16_t*)(ws + WO_W2D); j.K = DFF; j.N = DM; j.item = r; return j; } r -= CI_FF;
    j.N = 512;
    if (r < CI_Q) { j.W = a.in[10] + (size_t)layer * DM * 512; j.WT = (bf16_t*)(ws + WO_WQ); j.kscale = nb + 4 * DM; j.item = r; return j; } r -= CI_Q;
    if (r < CI_Q) { j.W = a.in[11] + (size_t)layer * DM * 512; j.WT = (bf16_t*)(ws + WO_WKV); j.item = r; return j; } r -= CI_Q;
    if (r < CI_Q) { j.W = a.in[12] + (size_t)layer * DM * 512; j.WT = (bf16_t*)(ws + WO_WKV); j.roff = 512; j.item = r; return j; } r -= CI_Q;
    if (r < CI_WO) { j.W = a.in[13] + (size_t)layer * 512 * DM; j.WT = (bf16_t*)(ws + WO_WO); j.K = 512; j.N = DM; j.item = r; return j; } r -= CI_WO;
    if (layer == 0) {
        if (r < CI_IN) { j.W = a.in[14]; j.WT = (bf16_t*)(ws + WO_WIN); j.N = INW; j.kscale = nb + 2 * DM; j.item = r; return j; } r -= CI_IN;
        j.W = a.in[15]; j.WT = (bf16_t*)(ws + WO_WOUT); j.N = DM; j.item = r; return j;
    }
    const int gi = r / CI_PL; r -= gi * CI_PL;
    j.W = a.in[21] + (size_t)gi * 512 * 512; j.WT = (bf16_t*)(ws + WO_WPOOL); j.K = 512; j.N = 512; j.roff = gi * 512; j.scale = a.in[22] + gi * 512; j.item = r; return j;
}
__device__ __forceinline__ void conv_load(const ConvJob& j, int lane, float (&v)[32]) {
    const int nblk = j.N / 32, kb = j.item / nblk, nb = j.item % nblk;
    const GAS float* Wg = (const GAS float*)j.W + (size_t)(64 * kb + (lane >> 5)) * j.N + 32 * nb + (lane & 31);
#pragma unroll
    for (int i = 0; i < 32; ++i) v[i] = Wg[(size_t)(2 * i) * j.N];
}
__device__ __forceinline__ void conv_finish(const ConvJob& j, LAS float* scr, int lane, const float (&v)[32]) {
    const int nblk = j.N / 32, kb = j.item / nblk, nb = j.item % nblk, k0 = 64 * kb, n0 = 32 * nb;
    const float sc = j.scale ? ((const GAS float*)j.scale)[n0 + (lane & 31)] : 1.0f;
#pragma unroll
    for (int i = 0; i < 32; ++i) scr[(2 * i + (lane >> 5)) * 33 + (lane & 31)] = v[i] * sc;
    asm volatile("s_waitcnt lgkmcnt(0)" ::: "memory");
    const int drow0 = (j.mode == 0) ? (j.roff + n0) : (256 * (n0 >> 7) + (n0 & 127) + (j.mode == 2 ? 128 : 0));
    const int c = lane & 7;
    f32x4 ka = (f32x4){1.f, 1.f, 1.f, 1.f}, kc = ka;
    if (j.kscale) { ka = *(const GAS f32x4*)((const GAS float*)j.kscale + k0 + 8 * c); kc = *(const GAS f32x4*)((const GAS float*)j.kscale + k0 + 8 * c + 4); }
#pragma unroll
    for (int q = 0; q < 4; ++q) { const int n = (lane >> 3) + 8 * q; const LAS float* s = scr + (8 * c) * 33 + n;
        u32x4 o; o.x = cvt_pk_bf16(s[0 * 33] * ka[0], s[1 * 33] * ka[1]); o.y = cvt_pk_bf16(s[2 * 33] * ka[2], s[3 * 33] * ka[3]); o.z = cvt_pk_bf16(s[4 * 33] * kc[0], s[5 * 33] * kc[1]); o.w = cvt_pk_bf16(s[6 * 33] * kc[2], s[7 * 33] * kc[3]);
        *(GAS u32x4*)((GAS bf16_t*)j.WT + (size_t)(drow0 + n) * j.K + k0 + 8 * c) = o; }
    asm volatile("s_waitcnt lgkmcnt(0)" ::: "memory");
}
__device__ __forceinline__ void conv_all(const Args& a, LAS unsigned char* lds, int wid, int lane, int gw, int ngw) {
    LAS float* scr = (LAS float*)(lds + wid * 16384);
    constexpr int NT = CI_L0 + CI_L1;
    for (int it = gw; it < NT; it += 2 * ngw) {
        const bool h1 = (it + ngw) < NT;
        const ConvJob j0 = conv_decode(a, it), j1 = conv_decode(a, h1 ? it + ngw : it);
        float v0[32], v1[32];
        conv_load(j0, lane, v0); conv_load(j1, lane, v1);
        asm volatile("" ::: "memory");
        conv_finish(j0, scr, lane, v0);
        if (h1) conv_finish(j1, scr, lane, v1);
    }
    for (int layer = 0; layer < 2; ++layer)
        norm_pass(a.in[1], nullptr, nullptr, nullptr, 0.f, nullptr, a.in[3] + layer * DM, (bf16_t*)(a.ws + WS_MEMN + (size_t)layer * 4 * MiB), MEMROWS, gw, ngw, lane);
}

__global__ void __launch_bounds__(512, 2) mega_fwd(Args a) {
    extern __shared__ __attribute__((aligned(16))) unsigned char lds_raw[];
    LAS unsigned char* lds = (LAS unsigned char*)lds_raw;
    cg::grid_group grid = cg::this_grid();
    const int tid = threadIdx.x, lane = tid & 63, wid = __builtin_amdgcn_readfirstlane(tid >> 6);
    const int G = gridDim.x, bx = blockIdx.x;
    const int gw = bx * 8 + wid, ngw = G * 8;
    unsigned char* ws = a.ws;
    bf16_t* Hb = (bf16_t*)(ws + WS_H); float* RS = (float*)(ws + WS_RS);
    bf16_t* HID = (bf16_t*)(ws + WS_HID); bf16_t* Zb = (bf16_t*)(ws + WS_Z); bf16_t* CAT = (bf16_t*)(ws + WS_CAT); bf16_t* POOLB = (bf16_t*)(ws + WS_POOL);
    bf16_t* Qb = (bf16_t*)(ws + WS_Q); bf16_t* Ob = (bf16_t*)(ws + WS_O);
    f32x2* rope = (f32x2*)(ws + WS_ROPE); f32x2* sst = (f32x2*)(ws + WS_SST); bf16_t* SGUW = (bf16_t*)(ws + WS_SGUW);
    const float* norms = a.in[2];
    const int lo = a.ph_lo, hi = a.ph_hi;
    int gp = 0;
    volatile LAS unsigned* MISC = (volatile LAS unsigned*)(lds + LDS_BYTES - 64);
    if (tid < 16) MISC[tid] = 0u;
    __syncthreads();
    XcdBarrier xbar = xcd_barrier_post((unsigned*)ws, MISC);
#define SEAM() do { if (gp + 1 < hi) { if (a.inv[0] < 0.f) grid.sync(); else xcd_barrier(xbar); } } while (0)
#define SEAM_X() do { if (gp + 1 < hi) xcd_barrier(xbar); } while (0)

    if (gp >= lo && gp < hi) {
        prep_pass(a.in[0], Hb, RS, MTOK, gw, ngw, lane);
        conv_all(a, lds, wid, lane, gw, ngw);
        for (int idx = bx * 512 + tid; idx < SEQ * 8; idx += G * 512) {
            const int pos = idx >> 3, k = idx & 7;
            const float ang = (float)pos * a.inv[k];
            double rev = (double)ang * 0.15915494309189535; rev -= floor(rev);
            const float fr = (float)rev;
            ((GAS f32x2*)rope)[idx] = (f32x2){__builtin_amdgcn_cosf(fr), __builtin_amdgcn_sinf(fr)};
        }
        for (int idx = bx * 512 + tid; idx < MTOK * 8; idx += G * 512) ((GAS unsigned long long*)(ws + WS_XB))[idx] = 0ull;
        for (int idx = bx * 512 + tid; idx < 8 * 128 * 128; idx += G * 512) {
            const int i = (idx >> 7) & 127, j = idx & 127;
            const float v = (j <= i) ? ((const GAS float*)a.in[19])[idx] : 0.f;
            ((GAS bf16_t*)SGUW)[idx] = (bf16_t)(cvt_pk_bf16(v, 0.f) & 0xffffu);
        }
        SEAM();
    }
    ++gp;

#pragma unroll 1
    for (int layer = 0; layer < 2; ++layer) {
        const float* gl = norms + layer * 8 * DM;
        const unsigned char* wl = ws + WS_WL + (size_t)layer * WL_STRIDE;
#pragma unroll 1
        for (int p = 0; p < 10; ++p) {
            if ((layer == 1 && p == 3) || p == 6) continue;
            if (gp >= lo && gp < hi) {
                const int tid = fresh_tid(), lane = tid & 63, wid = __builtin_amdgcn_readfirstlane(tid >> 6);
                if (p == 0 || p == 8) {
                    pg8::Gemm g{Hb, (const bf16_t*)(wl + (p == 0 ? WO_W1A : WO_W2A)), MTOK, 2 * DFF, DM, DM, DM, 0, 0u};
                    pg8::StaticOrder S; S.init(MTOK, 2 * DFF, G, bx);
                    const pg8::RsFill<pg8::StaticOrder> F{(LAS float*)(lds + XL_OFF), RS, &S, tid};
                    pg8::EpiSwiglu E{HID, RS, (const LAS float*)(lds + XL_OFF)};
                    pg8::gemm_phase<pg8::EpiSwiglu, pg8::StaticOrder, false, pg8::RsFill<pg8::StaticOrder>>(lds, g, S, E, F);
                } else if (p == 1 || p == 9 || p == 4 || p == 7) {
                    pg8::Gemm g;
                    if (p == 1 || p == 9) g = pg8::Gemm{HID, (const bf16_t*)(wl + (p == 1 ? WO_W1D : WO_W2D)), MTOK, DM, DFF, DFF, DFF, 0, 0u};
                    else if (p == 7) g = pg8::Gemm{Ob, (const bf16_t*)(wl + WO_WO), MTOK, DM, 512, 512, 512, 0, 0u};
                    else if (layer == 0) g = pg8::Gemm{CAT, (const bf16_t*)(wl + WO_WOUT), MTOK, DM, DM, DM, DM, 0, 0u};
                    else g = pg8::Gemm{POOLB, (const bf16_t*)(wl + WO_WPOOL), MTOK, DM, 512, DM, 512, 1, 1024u};
                    const int gi = (p == 1) ? 1 : (p == 4) ? 3 : (p == 7) ? 5 : 7;
                    const int seq = layer * 4 + (gi >> 1);
                    const bool final_ = (p == 9 && layer == 1);
                    pg8::PanelOrder S; S.init(MTOK, G, bx);
                    pg8::EpiNorm E{Hb, final_ ? a.out : nullptr, RS, gl + gi * DM, (p == 1 || p == 9) ? 0.5f : 1.0f,
                                   (float*)(ws + WS_XB), (unsigned*)(ws + WS_CNT), (unsigned)(seq + 1), lds + XL_OFF};
                    pg8::gemm_phase<pg8::EpiNorm, pg8::PanelOrder>(lds, g, S, E);
                } else if (p == 2) {
                    if (layer == 0) {
                        pg8::Gemm g{Hb, (const bf16_t*)(wl + WO_WIN), MTOK, INW, DM, DM, DM, 0, 0u};
                        pg8::StaticOrder S; S.init(MTOK, INW, G, bx);
                        fill_rs_table((LAS float*)(lds + XL_OFF), RS, S, tid);
                        pg8::EpiAct E{Zb, INW, 5, 9, sst, RS, (const LAS float*)(lds + XL_OFF)};
                        for (int k = 0; k < 3; ++k) {
                            if (k > 0) {
                                const unsigned char* wk = ws + WS_WL + (size_t)(k - 1) * WL_STRIDE;
                                g = pg8::Gemm{(const bf16_t*)(ws + WS_MEMN + (size_t)(k - 1) * 4 * MiB), (const bf16_t*)(wk + WO_WKV), MEMROWS, 1024, DM, DM, DM, 0, 0u};
                                S.init(MEMROWS, 1024, G, G > 96 ? (bx + G - 64 - 16 * (k - 1)) % G : bx);
                                E = pg8::EpiAct{(bf16_t*)(ws + WS_KV + (size_t)(k - 1) * 2 * MiB), 1024, 1 << 30, 1 << 30, sst, nullptr, nullptr};
                            }
                            pg8::gemm_phase<pg8::EpiAct, pg8::StaticOrder>(lds, g, S, E);
                        }
                    } else {
                        for (int u = bx; u < MTOK / 32; u += G) pool_unit(lds, Hb, RS, gl + 2 * DM, POOLB, u, tid);
                    }
                } else if (p == 3) {
                    for (int u = bx; u < 256 + 1024; u += G) {
                        if (u < 256) attn_unit(lds, Zb, CAT, rope, a.in[16], u, tid, wid, lane);
                        else sgu_unit(lds, Zb, CAT, sst, SGUW, a.in[17], a.in[18], a.in[20], u - 256, tid, wid, lane);
                    }
                } else if (p == 5) {
                    pg8::Gemm g{Hb, (const bf16_t*)(wl + WO_WQ), MTOK, 512, DM, DM, DM, 0, 0u};
                    pg8::StaticOrder S; S.init(MTOK, 1024, G, bx);
                    fill_rs_table((LAS float*)(lds + XL_OFF), RS, S, tid);
                    pg8::EpiHalf E{Qb, 512, RS, (const LAS float*)(lds + XL_OFF)};
                    pg8::gemm_phase<pg8::EpiHalf, pg8::StaticOrder, true>(lds, g, S, E);
                    const bf16_t* kvl = (const bf16_t*)(ws + WS_KV + (size_t)layer * 2 * MiB);
                    pg8::Unit u;
                    for (int i = 0; S.next(i, u); ++i) xattn_unit(lds, Qb, kvl, Ob, ((u.pm >> 4) * 4 + u.pn) * 16 + (u.pm & 15), tid, wid, lane);
                }
                if (!(layer == 1 && p == 9)) SEAM_X();
            }
            ++gp;
        }
    }
#undef SEAM
#undef SEAM_X
}

extern "C" void kernel_launch(void* const* d_in, const int* in_sizes, int n_in, void* d_out, int out_size, void* d_ws, size_t ws_size, hipStream_t stream) {
    static int grid = 0;
    if (grid == 0) {
        if (n_in != 23 || out_size != MTOK * DM || ws_size < WS_END) { fprintf(stderr, "kernel_launch: unexpected problem (n_in %d, out %d, ws %zu)\n", n_in, out_size, ws_size); grid = -1; return; }
        int dev = 0, cus = 0, per_cu = 0;
        hipGetDevice(&dev);
        hipDeviceGetAttribute(&cus, hipDeviceAttributeMultiprocessorCount, dev);
        if (hipFuncSetAttribute((const void*)mega_fwd, hipFuncAttributeMaxDynamicSharedMemorySize, LDS_BYTES) != hipSuccess) { fprintf(stderr, "kernel_launch: hipFuncSetAttribute failed\n"); grid = -1; return; }
        if (hipOccupancyMaxActiveBlocksPerMultiprocessor(&per_cu, (const void*)mega_fwd, 512, LDS_BYTES) != hipSuccess || per_cu < 1) { fprintf(stderr, "kernel_launch: occupancy query gave %d\n", per_cu); per_cu = 1; }
        (void)hipGetLastError();
        grid = cus * per_cu; grid -= grid % 8;
        fprintf(stderr, "kernel_launch: grid %d (cus %d x %d)\n", grid, cus, per_cu);
    }
    if (grid < 0) return;
    if (hipMemsetAsync(d_ws, 0, 65536, stream) != hipSuccess) { fprintf(stderr, "kernel_launch: memset failed\n"); return; }
    Args a{};
    for (int i = 0; i < 23; ++i) a.in[i] = (const float*)d_in[i];
    a.out = (float*)d_out; a.ws = (unsigned char*)d_ws;
    for (int k = 0; k < 8; ++k) a.inv[k] = (float)pow(500000.0, -(double)k / 8.0);
    a.ph_lo = 0; a.ph_hi = 1000;
    void* args[] = {&a};
    hipError_t e = hipLaunchCooperativeKernel((const void*)mega_fwd, dim3(grid), dim3(512), args, LDS_BYTES, stream);
    if (e != hipSuccess) fprintf(stderr, "kernel_launch: cooperative launch failed: %s (grid %d)\n", hipGetErrorString(e), grid);
}
```

```cpp
#include <hip/hip_runtime.h>
#include <hip/hip_cooperative_groups.h>
#include <cstdio>
#include <cstdint>
#include <cmath>
namespace cg = cooperative_groups;

#define LAS __attribute__((address_space(3)))
#define GAS __attribute__((address_space(1)))
typedef unsigned short bf16_t;
typedef short bf16x8 __attribute__((ext_vector_type(8)));
typedef short s16x4 __attribute__((ext_vector_type(4)));
typedef float f32x4 __attribute__((ext_vector_type(4)));
typedef float f32x2 __attribute__((ext_vector_type(2)));
typedef unsigned u32x4 __attribute__((ext_vector_type(4)));
typedef unsigned u32x2 __attribute__((ext_vector_type(2)));

constexpr int MTOK = 16384, DM = 2048, DFF = 5632, SEQ = 4096, MEMROWS = 1024;
constexpr int INW = 3328;
constexpr float EPS = 1e-6f;

constexpr size_t MiB = 1u << 20;
constexpr size_t WS_CNT  = 16384;
constexpr size_t WS_ROPE = 1 * MiB;
constexpr size_t WS_XB   = 2 * MiB;
constexpr size_t WS_RS   = 3 * MiB;
constexpr size_t WS_SST  = 4 * MiB;
constexpr size_t WS_SGUW = 6 * MiB;
constexpr size_t WS_MEMN = 8 * MiB;
constexpr size_t WS_Q    = 16 * MiB;
constexpr size_t WS_O    = 32 * MiB;
constexpr size_t WS_KV   = 48 * MiB;
constexpr size_t WS_H    = 64 * MiB;
constexpr size_t WS_HID  = 128 * MiB;
constexpr size_t WS_Z    = 128 * MiB;
constexpr size_t WS_CAT  = 232 * MiB;
constexpr size_t WS_POOL = 128 * MiB;
constexpr size_t WS_WL   = 304 * MiB;
constexpr size_t WL_STRIDE = 164 * MiB;
constexpr size_t WO_W1A = 0, WO_W1D = 44 * MiB, WO_W2A = 66 * MiB, WO_W2D = 110 * MiB, WO_WQ = 132 * MiB, WO_WKV = 134 * MiB, WO_WO = 138 * MiB,
                 WO_WIN = 140 * MiB, WO_WOUT = 154 * MiB, WO_WPOOL = 140 * MiB;
constexpr size_t WS_END  = WS_WL + 2 * WL_STRIDE;

constexpr int LDS_BYTES = 147456;
constexpr int XL_OFF = 131072;

typedef __bf16 bf16x2_t __attribute__((ext_vector_type(2)));
__device__ __forceinline__ unsigned cvt_pk_bf16(float lo, float hi) { const f32x2 v = {lo, hi}; const bf16x2_t b = __builtin_convertvector(v, bf16x2_t); return __builtin_bit_cast(unsigned, b); }
__device__ __forceinline__ float bflo(unsigned w) { return __uint_as_float(w << 16); }
__device__ __forceinline__ float bfhi(unsigned w) { return __uint_as_float(w & 0xffff0000u); }
__device__ __forceinline__ float wave_sum(float v) {
#pragma unroll
    for (int o = 1; o < 64; o <<= 1) v += __shfl_xor(v, o);
    return v;
}
__device__ __forceinline__ float gelu_tanh(float x) {
    const float inner = 1.5957691216057308f * (x + 0.044715f * x * x * x);
    return x * __builtin_amdgcn_rcpf(1.0f + __expf(-inner));
}
__device__ __forceinline__ float silu_f(float x) { return x * __builtin_amdgcn_rcpf(1.0f + __expf(-x)); }
__device__ __forceinline__ int fresh_tid() { int t = threadIdx.x; asm volatile("" : "+v"(t)); return t; }
__device__ __forceinline__ float row_rs(const float* rsp, int row) {
    const f32x4 a = *(const GAS f32x4*)((const GAS float*)rsp + (size_t)row * 8), b = *(const GAS f32x4*)((const GAS float*)rsp + (size_t)row * 8 + 4);
    return __builtin_amdgcn_rsqf((((a[0] + a[1]) + (a[2] + a[3])) + ((b[0] + b[1]) + (b[2] + b[3]))) * (1.0f / DM) + EPS);
}
constexpr int RS_TABLE_UNITS = 15;
__device__ __forceinline__ float rs_lookup(const LAS float* T, const float* rsp, int ord, int pm, int lrow) {
    return (ord < RS_TABLE_UNITS) ? T[ord * 256 + lrow] : row_rs(rsp, pm * 256 + lrow);
}
__device__ __forceinline__ void rs_lookup8(float (&rsv)[8], const LAS float* T, const float* rsp, int ord, int pm, int lrow0) {
    if (ord < RS_TABLE_UNITS) {
#pragma unroll
        for (int q = 0; q < 8; ++q) rsv[q] = T[ord * 256 + lrow0 + (q >> 2) * 128 + (q & 3) * 16];
    } else {
#pragma unroll
        for (int q = 0; q < 8; ++q) rsv[q] = row_rs(rsp, pm * 256 + lrow0 + (q >> 2) * 128 + (q & 3) * 16);
    }
}
#define MFMA16(a, b, c) __builtin_amdgcn_mfma_f32_16x16x32_bf16((a), (b), (c), 0, 0, 0)

namespace pg8 {
constexpr int BM = 256, BK = 64, HALF = 128, HTB = HALF * BK * 2, STAGE_BYTES = 8 * HTB, NXCD = 8, WGM = 8;
__host__ __device__ __forceinline__ int lds_byte(int r, int c) { const int st = (r >> 4) * 2 + (c >> 5), rr = r & 15, cc = c & 31, ob = rr * 64 + cc * 2; return st * 1024 + (ob ^ (((ob >> 9) & 1) << 5)); }
__host__ __device__ __forceinline__ void stage_rc(int b, int& R, int& C) { const int st = b / 1024, sb = b % 1024, swz = sb ^ (((sb >> 9) & 1) << 5); R = (st >> 1) * 16 + swz / 64; C = (st & 1) * 32 + (swz % 64) / 2; }
__host__ __device__ __forceinline__ int perm32(int rho) { const int n = rho >> 4, i = rho & 15; return 8 * (i >> 2) + 4 * n + (i & 3); }

struct Unit { int pm, pn, ord; };
struct Gemm { const bf16_t* A; const bf16_t* Bt; int M, N, K, lda, ldb, a_shift; unsigned a_stride; };

struct StaticOrder {
    int nM, nN, nwg, G, c;
    __device__ void init(int M, int N, int G_, int c_) { nM = M / BM; nN = N / BM; nwg = nM * nN; G = G_; c = c_; }
    __device__ bool next(int i, Unit& u) const {
        const long L = (long)i * G + c; if (L >= nwg) return false;
        int wgid = (int)L; { const int q = nwg / NXCD, r = nwg % NXCD, xcd = wgid % NXCD, off = wgid / NXCD; wgid = (xcd < r ? xcd * (q + 1) : r * (q + 1) + (xcd - r) * q) + off; }
        const int nig = WGM * nN, gid = wgid / nig, fm = gid * WGM, gsz = (nM - fm) < WGM ? (nM - fm) : WGM;
        u.pm = fm + ((wgid % nig) % gsz); u.pn = (wgid % nig) / gsz; return true;
    }
};


struct EpiAct {
    bf16_t* O; int ldc; int gelu_from, stat_from; f32x2* st;
    const float* rs; const LAS float* T;
    __device__ __forceinline__ void operator()(const f32x4 (&acc)[2][2][4][2], const Unit& u, int wr, int wc, int fr, int fq) const {
        const int row0 = u.pm * BM + wr * 64 + fr, col0 = u.pn * BM + wc * 32 + 8 * fq;
        const bool do_gelu = u.pn >= gelu_from, do_stat = u.pn >= stat_from;
        float rsv8[8];
        if (rs) rs_lookup8(rsv8, T, rs, u.ord, u.pm, wr * 64 + fr);
        else {
#pragma unroll
            for (int q = 0; q < 8; ++q) rsv8[q] = 1.0f;
        }
#pragma unroll
        for (int ai = 0; ai < 2; ++ai)
#pragma unroll
            for (int m = 0; m < 4; ++m) {
                const int row = row0 + ai * HALF + m * 16;
                GAS bf16_t* rowp = (GAS bf16_t*)O + (size_t)row * ldc + col0;
                const float rsv = rsv8[ai * 4 + m];
                float s1 = 0.f, s2 = 0.f;
#pragma unroll
                for (int bj = 0; bj < 2; ++bj) {
                    f32x4 v0 = acc[ai][bj][m][0] * rsv, v1 = acc[ai][bj][m][1] * rsv;
                    if (do_gelu) {
#pragma unroll
                        for (int e = 0; e < 4; ++e) { v0[e] = gelu_tanh(v0[e]); v1[e] = gelu_tanh(v1[e]); }
                    }
                    if (do_stat) {
#pragma unroll
                        for (int e = 0; e < 4; ++e) { s1 += v0[e] + v1[e]; s2 += v0[e] * v0[e] + v1[e] * v1[e]; }
                    }
                    u32x4 w; w.x = cvt_pk_bf16(v0[0], v0[1]); w.y = cvt_pk_bf16(v0[2], v0[3]); w.z = cvt_pk_bf16(v1[0], v1[1]); w.w = cvt_pk_bf16(v1[2], v1[3]);
                    *(GAS u32x4*)(rowp + bj * HALF) = w;
                }
                if (do_stat) {
                    s1 += __shfl_xor(s1, 16); s1 += __shfl_xor(s1, 32); s2 += __shfl_xor(s2, 16); s2 += __shfl_xor(s2, 32);
                    if (fq == 0) ((GAS f32x2*)st)[(size_t)((u.pn - stat_from) * 4 + wc) * MTOK + row] = (f32x2){s1, s2};
                }
            }
    }
};
struct EpiHalf {
    bf16_t* O; int ldc; const float* rs; const LAS float* T;
    __device__ __forceinline__ void operator()(const f32x4 (&acc)[2][2][4][2], const Unit& u, int wr, int wc, int fr, int fq) const {
        const int row0 = u.pm * BM + wr * 64 + fr, col0 = u.pn * HALF + wc * 32 + 8 * fq;
        float rsv8[8];
        rs_lookup8(rsv8, T, rs, u.ord, u.pm, wr * 64 + fr);
#pragma unroll
        for (int ai = 0; ai < 2; ++ai)
#pragma unroll
            for (int m = 0; m < 4; ++m) {
                const int row = row0 + ai * HALF + m * 16;
                const float rsv = rsv8[ai * 4 + m];
                const f32x4 v0 = acc[ai][0][m][0] * rsv, v1 = acc[ai][0][m][1] * rsv;
                u32x4 w; w.x = cvt_pk_bf16(v0[0], v0[1]); w.y = cvt_pk_bf16(v0[2], v0[3]); w.z = cvt_pk_bf16(v1[0], v1[1]); w.w = cvt_pk_bf16(v1[2], v1[3]);
                *(GAS u32x4*)((GAS bf16_t*)O + (size_t)row * ldc + col0) = w;
            }
    }
};
struct EpiSwiglu {
    bf16_t* O; const float* rs; const LAS float* T;
    __device__ __forceinline__ void operator()(const f32x4 (&acc)[2][2][4][2], const Unit& u, int wr, int wc, int fr, int fq) const {
        const int row0 = u.pm * BM + wr * 64 + fr, col0 = u.pn * HALF + wc * 32 + 8 * fq;
        float rsv[8], irs2[8];
        rs_lookup8(rsv, T, rs, u.ord, u.pm, wr * 64 + fr);
#pragma unroll
        for (int q = 0; q < 8; ++q) irs2[q] = __builtin_amdgcn_rcpf(rsv[q] * rsv[q]);
#pragma unroll
        for (int ai = 0; ai < 2; ++ai)
#pragma unroll
            for (int mp = 0; mp < 2; ++mp) {
                f32x2 gg[8], ee[8];
#pragma unroll
                for (int q = 0; q < 8; ++q) {
                    const int m = 2 * mp + (q >> 2), n = (q >> 1) & 1, h2 = q & 1;
                    gg[q] = (f32x2){acc[ai][0][m][n][2 * h2], acc[ai][0][m][n][2 * h2 + 1]};
                    const f32x2 a2 = gg[q] * (rsv[ai * 4 + m] * -1.4426950408889634f);
                    ee[q].x = __builtin_amdgcn_exp2f(a2.x); ee[q].y = __builtin_amdgcn_exp2f(a2.y);
                }
#pragma unroll
                for (int q = 0; q < 8; ++q) { const float ir = irs2[ai * 4 + 2 * mp + (q >> 2)]; const f32x2 d2 = ee[q] * ir + ir;
                    ee[q].x = __builtin_amdgcn_rcpf(d2.x); ee[q].y = __builtin_amdgcn_rcpf(d2.y); }
                u32x4 w[2];
#pragma unroll
                for (int q = 0; q < 8; ++q) {
                    const int m = 2 * mp + (q >> 2), n = (q >> 1) & 1, h2 = q & 1;
                    const f32x2 u2 = {acc[ai][1][m][n][2 * h2], acc[ai][1][m][n][2 * h2 + 1]};
                    const f32x2 o2 = (gg[q] * u2) * ee[q];
                    w[q >> 2][(q & 3)] = cvt_pk_bf16(o2.x, o2.y);
                }
#pragma unroll
                for (int k = 0; k < 2; ++k) *(GAS u32x4*)((GAS bf16_t*)O + (size_t)(row0 + ai * HALF + (2 * mp + k) * 16) * DFF + col0) = w[k];
            }
    }
};
struct PanelOrder {
    int nwg, G, vcu;
    __device__ void init(int M, int G_, int c_) { nwg = (M / BM) * 8; G = G_; vcu = (c_ % 8) * (G_ / 8) + c_ / 8; }
    __device__ bool next(int i, Unit& u) const { const long L = (long)i * G + vcu; if (L >= nwg) return false; u.pm = (int)(L >> 3); u.pn = (int)(L & 7); return true; }
};
struct EpiNorm {
    bf16_t* XB; float* OUT; float* rs; const float* g_post; float wgt;
    float* xb; unsigned* cnt; unsigned want; LAS unsigned char* xl;
    __device__ __forceinline__ void exchange_post(const f32x4 (&v)[2][2][4][2], const Unit& u, int wr, int wc, int fr, int fq, int wid, int lane, int which) const {
        LAS float* P = (LAS float*)xl;
        float q8[8];
#pragma unroll
        for (int ai = 0; ai < 2; ++ai)
#pragma unroll
            for (int m = 0; m < 4; ++m) {
                float q = 0.f;
#pragma unroll
                for (int bj = 0; bj < 2; ++bj)
#pragma unroll
                    for (int n = 0; n < 2; ++n) { const f32x4 x = v[ai][bj][m][n]; q += (x[0] * x[0] + x[1] * x[1]) + (x[2] * x[2] + x[3] * x[3]); }
                q8[ai * 4 + m] = q;
            }
        { float t8[8];
#pragma unroll
          for (int r = 0; r < 8; ++r) t8[r] = __shfl_xor(q8[r], 16);
#pragma unroll
          for (int r = 0; r < 8; ++r) q8[r] += t8[r];
#pragma unroll
          for (int r = 0; r < 8; ++r) t8[r] = __shfl_xor(q8[r], 32);
#pragma unroll
          for (int r = 0; r < 8; ++r) q8[r] += t8[r]; }
        if (fq == 0) {
#pragma unroll
            for (int r = 0; r < 8; ++r) P[((r >> 2) * HALF + wr * 64 + (r & 3) * 16 + fr) * 4 + wc] = q8[r];
        }
        asm volatile("s_waitcnt lgkmcnt(0)" ::: "memory"); __builtin_amdgcn_s_barrier(); asm volatile("" ::: "memory");
        const int row = wid * 32 + (lane & 31);
        unsigned long long* slots = (unsigned long long*)xb + ((size_t)u.pm * BM + row) * 8;
        if (lane < 32) {
            const float t = (P[row * 4 + 0] + P[row * 4 + 1]) + (P[row * 4 + 2] + P[row * 4 + 3]);
            __hip_atomic_store(slots + u.pn, ((unsigned long long)want << 32) | (unsigned long long)__float_as_uint(t), __ATOMIC_RELAXED, __HIP_MEMORY_SCOPE_AGENT);
        }
    }
    __device__ __forceinline__ void exchange_wait(const Unit& u, int wid, int lane, int which, float scale) const {
        LAS float* S = (LAS float*)(xl + 4096);
        const int row = wid * 32 + (lane & 31);
        unsigned long long* slots = (unsigned long long*)xb + ((size_t)u.pm * BM + row) * 8;
        float t = 0.f; bool done = lane >= 32;
        for (unsigned it = 0; it < (1u << 15); ++it) {
            if (!done) {
                bool ok = true; float acc = 0.f;
#pragma unroll
                for (int h4 = 0; h4 < 2; ++h4) {
                    unsigned long long w[4];
#pragma unroll
                    for (int k = 0; k < 4; ++k) w[k] = __hip_atomic_load(slots + 4 * h4 + k, __ATOMIC_RELAXED, __HIP_MEMORY_SCOPE_AGENT);
#pragma unroll
                    for (int k = 0; k < 4; ++k) { ok = ok && ((unsigned)(w[k] >> 32) == want); acc += __uint_as_float((unsigned)w[k]); }
                    asm volatile("" ::: "memory");
                }
                if (ok) { t = acc; done = true; }
            }
            if (!__any(!done)) break;
            __builtin_amdgcn_s_sleep(1);
        }
        if (lane < 32) S[row] = scale * rsqrtf(t * (1.0f / DM) + EPS);
        asm volatile("s_waitcnt vmcnt(0) lgkmcnt(0)" ::: "memory"); __builtin_amdgcn_s_barrier(); asm volatile("" ::: "memory");
    }
    __device__ __forceinline__ void publish(const f32x4 (&v)[2][2][4][2], const Unit& u, int wr, int wc, int fr, int fq, int wid, int lane) const {
        LAS float* P = (LAS float*)xl;
        float q8[8];
#pragma unroll
        for (int ai = 0; ai < 2; ++ai)
#pragma unroll
            for (int m = 0; m < 4; ++m) {
                float q = 0.f;
#pragma unroll
                for (int bj = 0; bj < 2; ++bj)
#pragma unroll
                    for (int n = 0; n < 2; ++n) { const f32x4 x = v[ai][bj][m][n]; q += (x[0] * x[0] + x[1] * x[1]) + (x[2] * x[2] + x[3] * x[3]); }
                q8[ai * 4 + m] = q;
            }
        { float t8[8];
#pragma unroll
          for (int r = 0; r < 8; ++r) t8[r] = __shfl_xor(q8[r], 16);
#pragma unroll
          for (int r = 0; r < 8; ++r) q8[r] += t8[r];
#pragma unroll
          for (int r = 0; r < 8; ++r) t8[r] = __shfl_xor(q8[r], 32);
#pragma unroll
          for (int r = 0; r < 8; ++r) q8[r] += t8[r]; }
        if (fq == 0) {
#pragma unroll
            for (int r = 0; r < 8; ++r) P[((r >> 2) * HALF + wr * 64 + (r & 3) * 16 + fr) * 4 + wc] = q8[r];
        }
        asm volatile("s_waitcnt lgkmcnt(0)" ::: "memory"); __builtin_amdgcn_s_barrier(); asm volatile("" ::: "memory");
        const int row = wid * 32 + (lane & 31);
        if (lane < 32) ((GAS float*)rs)[((size_t)u.pm * BM + row) * 8 + u.pn] = (P[row * 4 + 0] + P[row * 4 + 1]) + (P[row * 4 + 2] + P[row * 4 + 3]);
    }
    __device__ __forceinline__ void operator()(f32x4 (&acc)[2][2][4][2], const Unit& u, int wr, int wc, int fr_in, int fq_in) const {
        int fr = fr_in, fq = fq_in; asm volatile("" : "+v"(fr), "+v"(fq));
        const int wid = wr * 4 + wc, lane = fq * 16 + fr;
        const LAS float* S = (const LAS float*)(xl + 4096);
        const int col0 = u.pn * BM + wc * 32 + 8 * fq;
        exchange_post(acc, u, wr, wc, fr, fq, wid, lane, 0);
        u32x4 xv[2][4][2];
#pragma unroll
        for (int ai = 0; ai < 2; ++ai)
#pragma unroll
            for (int m = 0; m < 3; ++m)
#pragma unroll
                for (int bj = 0; bj < 2; ++bj)
                    xv[ai][m][bj] = *(const GAS u32x4*)((const GAS bf16_t*)XB + ((size_t)u.pm * BM + ai * HALF + wr * 64 + m * 16 + fr) * DM + col0 + bj * HALF);
        exchange_wait(u, wid, lane, 0, wgt);
#pragma unroll
        for (int ai = 0; ai < 2; ++ai)
#pragma unroll
            for (int bj = 0; bj < 2; ++bj)
                xv[ai][3][bj] = *(const GAS u32x4*)((const GAS bf16_t*)XB + ((size_t)u.pm * BM + ai * HALF + wr * 64 + 3 * 16 + fr) * DM + col0 + bj * HALF);
        f32x4 gp[2][2];
#pragma unroll
        for (int bj = 0; bj < 2; ++bj)
#pragma unroll
            for (int n = 0; n < 2; ++n) gp[bj][n] = *(const GAS f32x4*)((const GAS float*)g_post + col0 + bj * HALF + 4 * n);
#pragma unroll
        for (int ai = 0; ai < 2; ++ai)
#pragma unroll
            for (int m = 0; m < 4; ++m) {
                const int r = ai * HALF + wr * 64 + m * 16 + fr; const float sr = S[r];
                const size_t off = ((size_t)u.pm * BM + r) * DM + col0;
#pragma unroll
                for (int bj = 0; bj < 2; ++bj) {
                    const u32x4 xw = xv[ai][m][bj];
                    const f32x4 x0 = (f32x4){bflo(xw.x), bfhi(xw.x), bflo(xw.y), bfhi(xw.y)}, x1 = (f32x4){bflo(xw.z), bfhi(xw.z), bflo(xw.w), bfhi(xw.w)};
                    const f32x4 o0 = x0 + acc[ai][bj][m][0] * gp[bj][0] * sr, o1 = x1 + acc[ai][bj][m][1] * gp[bj][1] * sr;
                    acc[ai][bj][m][0] = o0; acc[ai][bj][m][1] = o1;
                    if (OUT) { *(GAS f32x4*)((GAS float*)OUT + off + bj * HALF) = o0; *(GAS f32x4*)((GAS float*)OUT + off + bj * HALF + 4) = o1; }
                    else { u32x4 w; w.x = cvt_pk_bf16(o0[0], o0[1]); w.y = cvt_pk_bf16(o0[2], o0[3]); w.z = cvt_pk_bf16(o1[0], o1[1]); w.w = cvt_pk_bf16(o1[2], o1[3]);
                           *(GAS u32x4*)((GAS bf16_t*)XB + off + bj * HALF) = w; }
                }
            }
        if (!OUT) publish(acc, u, wr, wc, fr, fq, wid, lane);
    }
};

template <class Epi, class Sched, bool HALFN = false>
__device__ __forceinline__ void gemm_phase(LAS unsigned char* lds, const Gemm g, const Sched& S, const Epi& E) {
    const int tid = fresh_tid(), wid = __builtin_amdgcn_readfirstlane(tid >> 6), lane = tid & 63, wr = wid >> 2, wc = wid & 3, fr = lane & 15, fq = lane >> 4;
    const int nt = g.K / BK;
    unsigned voffA[2], voffB[2];
#pragma unroll
    for (int i = 0; i < 2; ++i) { int R, C; stage_rc(tid * 16 + i * 8192, R, C); const int Rb = (R & ~31) + perm32(R & 31);
        voffA[i] = (unsigned)(R * g.lda + C) * 2u; voffB[i] = (unsigned)(Rb * g.ldb + C) * 2u; }
    const size_t kstep = (size_t)(BK * 2);
    const size_t hA = (size_t)HALF * g.lda * 2, hB = (size_t)HALF * g.ldb * 2, tA = 2 * hA, tB = HALFN ? hB : 2 * hB;
    const unsigned ldsw = (unsigned)wid * 1024u;
    const int aoff = lds_byte(wr * 64 + fr, fq * 8), boff = lds_byte(wc * 32 + fr, fq * 8);
#define PG8_SA(b, h) (((b) * 2 + (h)) * HTB)
#define PG8_SB(b, h) ((4 + (b) * 2 + (h)) * HTB)
#define PG8_STAGE(bufoff, gbase, voff) do { _Pragma("unroll") for (int _i = 0; _i < 2; ++_i) \
        __builtin_amdgcn_global_load_lds((const GAS unsigned*)((const GAS char*)(gbase) + (voff)[_i]), (LAS unsigned*)(lds + (bufoff) + ldsw + _i * 8192), 16, 0, 0); } while (0)
#define PG8_LDA(dst, b, h) do { _Pragma("unroll") for (int m = 0; m < 4; ++m) _Pragma("unroll") for (int k = 0; k < 2; ++k) dst[m][k] = *(const LAS bf16x8*)(lds + PG8_SA(b, h) + aoff + m * 2048 + k * 1024); } while (0)
#define PG8_LDB(dst, b, h) do { _Pragma("unroll") for (int n = 0; n < 2; ++n) _Pragma("unroll") for (int k = 0; k < 2; ++k) dst[n][k] = *(const LAS bf16x8*)(lds + PG8_SB(b, h) + boff + n * 2048 + k * 1024); } while (0)
#define PG8_MMA(ai, bj, At, Bt) do { __builtin_amdgcn_s_setprio(1); _Pragma("unroll") for (int m = 0; m < 4; ++m) _Pragma("unroll") for (int n = 0; n < 2; ++n) _Pragma("unroll") for (int k = 0; k < 2; ++k) \
        acc[ai][bj][m][n] = __builtin_amdgcn_mfma_f32_16x16x32_bf16(Bt[n][k], At[m][k], acc[ai][bj][m][n], 0, 0, 0); __builtin_amdgcn_s_setprio(0); } while (0)
#define PG8_WAIT_V(n) asm volatile("s_waitcnt vmcnt(" #n ")" ::: "memory")
#define PG8_WAIT_L(n) asm volatile("s_waitcnt lgkmcnt(" #n ")" ::: "memory")
#define PG8_BAR __builtin_amdgcn_s_barrier()
#define PG8_SCHED __builtin_amdgcn_sched_barrier(0)
    Unit cur, nxt; int ui = 0;
    if (!S.next(0, cur)) return;
    cur.ord = 0;
    f32x4 acc[2][2][4][2];
#pragma unroll
    for (int a = 0; a < 2; ++a)
#pragma unroll
        for (int b = 0; b < 2; ++b)
#pragma unroll
            for (int m = 0; m < 4; ++m)
#pragma unroll
                for (int n = 0; n < 2; ++n) acc[a][b][m][n] = (f32x4){0.f, 0.f, 0.f, 0.f};
    bf16x8 At[4][2], B0[2][2], B1[2][2];
    const GAS char* cA = (const GAS char*)g.A + (size_t)cur.pm * tA + (size_t)(cur.pn >> g.a_shift) * g.a_stride;
    const GAS char* cB = (const GAS char*)g.Bt + (size_t)cur.pn * tB;
    PG8_STAGE(PG8_SB(0, 0), cB, voffB); PG8_STAGE(PG8_SB(0, 1), cB + hB, voffB); PG8_STAGE(PG8_SA(0, 0), cA, voffA); PG8_STAGE(PG8_SA(0, 1), cA + hA, voffA);
    if (wr == 1) PG8_BAR;
    PG8_WAIT_V(2); PG8_BAR;
    PG8_STAGE(PG8_SB(1, 0), cB + kstep, voffB); PG8_STAGE(PG8_SA(1, 0), cA + kstep, voffA); PG8_STAGE(PG8_SB(1, 1), cB + hB + kstep, voffB);
    PG8_WAIT_V(6); PG8_BAR;
    for (;;) {
        const bool has_next = S.next(ui + 1, nxt); nxt.ord = ui + 1;
        const GAS char* nA = has_next ? (const GAS char*)g.A + (size_t)nxt.pm * tA + (size_t)(nxt.pn >> g.a_shift) * g.a_stride : cA;
        const GAS char* nB = has_next ? (const GAS char*)g.Bt + (size_t)nxt.pn * tB : cB;
        for (int t = 0; t < nt; t += 2) {
            const bool last = (t == nt - 2);
            const GAS char* a1 = cA + (size_t)(t + 1) * kstep;
            const GAS char* a2 = last ? nA : cA + (size_t)(t + 2) * kstep; const GAS char* b2 = last ? nB : cB + (size_t)(t + 2) * kstep;
            const GAS char* a3 = a2 + kstep; const GAS char* b3 = b2 + kstep;
            PG8_LDB(B0, 0, 0); if constexpr (!HALFN) PG8_LDB(B1, 0, 1); PG8_SCHED; PG8_LDA(At, 0, 0); PG8_STAGE(PG8_SA(1, 1), a1 + hA, voffA);
            PG8_WAIT_V(8); PG8_WAIT_L(0); PG8_BAR; PG8_MMA(0, 0, At, B0); if constexpr (!HALFN) PG8_MMA(0, 1, At, B1); PG8_BAR; PG8_SCHED;
            PG8_LDA(At, 0, 1); PG8_STAGE(PG8_SB(0, 0), b2, voffB); PG8_STAGE(PG8_SB(0, 1), b2 + hB, voffB); PG8_STAGE(PG8_SA(0, 0), a2, voffA);
            PG8_WAIT_V(8); PG8_WAIT_L(0); PG8_BAR; PG8_MMA(1, 0, At, B0); if constexpr (!HALFN) PG8_MMA(1, 1, At, B1); PG8_BAR; PG8_SCHED;
            PG8_LDB(B0, 1, 0); if constexpr (!HALFN) PG8_LDB(B1, 1, 1); PG8_SCHED; PG8_LDA(At, 1, 0); PG8_STAGE(PG8_SA(0, 1), a2 + hA, voffA);
            PG8_WAIT_V(8); PG8_WAIT_L(0); PG8_BAR; PG8_MMA(0, 0, At, B0); if constexpr (!HALFN) PG8_MMA(0, 1, At, B1); PG8_BAR; PG8_SCHED;
            PG8_LDA(At, 1, 1); PG8_STAGE(PG8_SB(1, 0), b3, voffB); PG8_STAGE(PG8_SB(1, 1), b3 + hB, voffB); PG8_STAGE(PG8_SA(1, 0), a3, voffA);
            PG8_WAIT_V(8); PG8_WAIT_L(0); PG8_BAR; PG8_MMA(1, 0, At, B0); if constexpr (!HALFN) PG8_MMA(1, 1, At, B1); PG8_BAR; PG8_SCHED;
        }
        if (wr == 0) PG8_BAR;
        E(acc, cur, wr, wc, fr, fq);
        if (!has_next) break;
#pragma unroll
        for (int a = 0; a < 2; ++a)
#pragma unroll
            for (int b = 0; b < 2; ++b)
#pragma unroll
                for (int m = 0; m < 4; ++m)
#pragma unroll
                    for (int n = 0; n < 2; ++n) acc[a][b][m][n] = (f32x4){0.f, 0.f, 0.f, 0.f};
        cur = nxt; cA = nA; cB = nB; ++ui;
        if (wr == 1) PG8_BAR;
    }
    PG8_WAIT_V(0);
    PG8_BAR;
#undef PG8_SA
#undef PG8_SB
#undef PG8_STAGE
#undef PG8_LDA
#undef PG8_LDB
#undef PG8_MMA
#undef PG8_WAIT_V
#undef PG8_WAIT_L
#undef PG8_BAR
#undef PG8_SCHED
}
}

__device__ __forceinline__ void norm_pass(const float* xin, float* xout, const float* y, const float* part, float wgt, const float* g_post, const float* g_pre, bf16_t* h,
                                          int nrows, int gw, int ngw, int lane) {
    for (int row = gw; row < nrows; row += ngw) {
        const GAS f32x4* xr = (const GAS f32x4*)(xin + (size_t)row * DM) + lane;
        f32x4 v[8];
#pragma unroll
        for (int j = 0; j < 8; ++j) v[j] = xr[64 * j];
        if (y) {
            const float ps = (lane < 32) ? ((const GAS float*)part)[(size_t)lane * MTOK + row] : 0.f;
            const float ss = wave_sum(ps);
            const float r = wgt * rsqrtf(ss * (1.0f / DM) + EPS);
            const GAS f32x4* yr = (const GAS f32x4*)(y + (size_t)row * DM) + lane; const GAS f32x4* gp = (const GAS f32x4*)g_post + lane;
#pragma unroll
            for (int j = 0; j < 8; ++j) v[j] += yr[64 * j] * gp[64 * j] * r;
        }
        if (xout) { GAS f32x4* xo = (GAS f32x4*)(xout + (size_t)row * DM) + lane;
#pragma unroll
            for (int j = 0; j < 8; ++j) xo[64 * j] = v[j]; }
        if (h) {
            float s2 = 0.f;
#pragma unroll
            for (int j = 0; j < 8; ++j) s2 += (v[j][0] * v[j][0] + v[j][1] * v[j][1]) + (v[j][2] * v[j][2] + v[j][3] * v[j][3]);
            s2 = wave_sum(s2);
            const float r2 = rsqrtf(s2 * (1.0f / DM) + EPS);
            const GAS f32x4* gq = (const GAS f32x4*)g_pre + lane; GAS u32x2* ho = (GAS u32x2*)(h + (size_t)row * DM) + lane;
#pragma unroll
            for (int j = 0; j < 8; ++j) { const f32x4 o = v[j] * gq[64 * j] * r2; u32x2 w; w.x = cvt_pk_bf16(o[0], o[1]); w.y = cvt_pk_bf16(o[2], o[3]); ho[64 * j] = w; }
        }
    }
}

__device__ __forceinline__ void prep_pass(const float* xin, bf16_t* xb, float* rs, int nrows, int gw, int ngw, int lane) {
    for (int row = gw; row < nrows; row += ngw) {
        const GAS f32x4* xr = (const GAS f32x4*)(xin + (size_t)row * DM) + lane;
        f32x4 v[8];
#pragma unroll
        for (int j = 0; j < 8; ++j) v[j] = xr[64 * j];
        float s2 = 0.f;
#pragma unroll
        for (int j = 0; j < 8; ++j) s2 += (v[j][0] * v[j][0] + v[j][1] * v[j][1]) + (v[j][2] * v[j][2] + v[j][3] * v[j][3]);
        s2 = wave_sum(s2);
        GAS u32x2* ho = (GAS u32x2*)(xb + (size_t)row * DM) + lane;
#pragma unroll
        for (int j = 0; j < 8; ++j) { u32x2 w; w.x = cvt_pk_bf16(v[j][0], v[j][1]); w.y = cvt_pk_bf16(v[j][2], v[j][3]); ho[64 * j] = w; }
        if (lane < 8) ((GAS float*)rs)[(size_t)row * 8 + lane] = (lane == 0) ? s2 : 0.f;
    }
}

__device__ __forceinline__ void rope_rot(const u32x4 x1, const u32x4 x2, const f32x2* tb, u32x4& r1, u32x4& r2) {
    const GAS f32x4* t = (const GAS f32x4*)tb;
#pragma unroll
    for (int p = 0; p < 4; ++p) {
        const f32x4 cc = t[p]; const f32x2 c0 = {cc[0], cc[1]}, c1 = {cc[2], cc[3]};
        const float a0 = bflo(x1[p]), a1 = bfhi(x1[p]), b0 = bflo(x2[p]), b1 = bfhi(x2[p]);
        r1[p] = cvt_pk_bf16(a0 * c0.x - b0 * c0.y, a1 * c1.x - b1 * c1.y);
        r2[p] = cvt_pk_bf16(b0 * c0.x + a0 * c0.y, b1 * c1.x + a1 * c1.y);
    }
}

__device__ __forceinline__ void rope_rot_t(const u32x4 x1, const u32x4 x2, const f32x4 (&cc)[4], u32x4& r1, u32x4& r2) {
#pragma unroll
    for (int p = 0; p < 4; ++p) {
        const f32x2 c0 = {cc[p][0], cc[p][1]}, c1 = {cc[p][2], cc[p][3]};
        const float a0 = bflo(x1[p]), a1 = bfhi(x1[p]), b0 = bflo(x2[p]), b1 = bfhi(x2[p]);
        r1[p] = cvt_pk_bf16(a0 * c0.x - b0 * c0.y, a1 * c1.x - b1 * c1.y);
        r2[p] = cvt_pk_bf16(b0 * c0.x + a0 * c0.y, b1 * c1.x + a1 * c1.y);
    }
}
constexpr int SA_KLD = 72, SA_VLD = 280;
__device__ __forceinline__ void attn_unit(LAS unsigned char* lds, const bf16_t* z, bf16_t* cat, const f32x2* rope, const float* sinks, int unit, int tid, int wid, int lane) {
    const int kvh = unit & 1, blk = (unit >> 1) & 31, b = unit >> 6;
    const int tokq = b * SEQ + blk * 128, tokk = tokq - 128;
    LAS bf16_t* Ks = (LAS bf16_t*)lds;
    LAS bf16_t* Vt = (LAS bf16_t*)(lds + 256 * SA_KLD * 2);
    const GAS bf16_t* zg = (const GAS bf16_t*)z;
    {
        u32x4 kva[4], vva[4], x1a[4], x2a[4]; f32x4 tba[4][4];
#pragma unroll
        for (int c = 0; c < 4; ++c) {
            const int idx = tid + 512 * c, key = idx >> 3, ch = idx & 7;
            const int pos = blk * 128 - 128 + key; const bool okp = pos >= 0;
            const GAS bf16_t* zr = zg + (size_t)(okp ? tokk + key : tokq) * INW;
            kva[c] = *(const GAS u32x4*)(zr + 1024 + kvh * 64 + ch * 8);
            vva[c] = *(const GAS u32x4*)(zr + 1152 + kvh * 64 + ch * 8);
            x1a[c] = *(const GAS u32x4*)(zr + 1024 + kvh * 64); x2a[c] = *(const GAS u32x4*)(zr + 1024 + kvh * 64 + 8);
            const GAS f32x4* tp = (const GAS f32x4*)(rope + (size_t)(okp ? pos : 0) * 8);
#pragma unroll
            for (int p = 0; p < 4; ++p) tba[c][p] = tp[p];
        }
        asm volatile("" ::: "memory");
#pragma unroll
        for (int c = 0; c < 4; ++c) {
            const int idx = tid + 512 * c, key = idx >> 3, ch = idx & 7;
            const bool okp = (blk * 128 - 128 + key) >= 0;
            u32x4 r1, r2; rope_rot_t(x1a[c], x2a[c], tba[c], r1, r2);
            u32x4 kv = ch == 0 ? r1 : (ch == 1 ? r2 : kva[c]), vv = vva[c];
            if (!okp) { kv = (u32x4){0u, 0u, 0u, 0u}; vv = (u32x4){0u, 0u, 0u, 0u}; }
            *(LAS u32x4*)(Ks + key * SA_KLD + ch * 8) = kv;
#pragma unroll
            for (int p = 0; p < 4; ++p) { Vt[(ch * 8 + 2 * p) * SA_VLD + key] = (bf16_t)(vv[p] & 0xffffu); Vt[(ch * 8 + 2 * p + 1) * SA_VLD + key] = (bf16_t)(vv[p] >> 16); }
        }
    }
    for (int idx = tid; idx < 64 * 24; idx += 512) Vt[(idx / 24) * SA_VLD + 256 + (idx % 24)] = 0;
    __syncthreads();
    const int hq = kvh * 8 + wid; const float sink = ((const GAS float*)sinks)[hq];
    const int qi = lane & 15, g = lane >> 4;
    for (int qs = 0; qs < 8; ++qs) {
        const int row = tokq + 16 * qs + qi, pos = blk * 128 + 16 * qs + qi;
        const GAS bf16_t* zr = zg + (size_t)row * INW + hq * 64;
        bf16x8 qf0, qf1;
        { const u32x4 x1 = *(const GAS u32x4*)(zr), x2 = *(const GAS u32x4*)(zr + 8); u32x4 r1, r2; rope_rot(x1, x2, rope + (size_t)pos * 8, r1, r2);
          const u32x4 own = *(const GAS u32x4*)(zr + 8 * g);
          const u32x4 sel = g == 0 ? r1 : (g == 1 ? r2 : own); qf0 = __builtin_bit_cast(bf16x8, sel); }
        qf1 = __builtin_bit_cast(bf16x8, *(const GAS u32x4*)(zr + 32 + 8 * g));
        f32x4 s[9];
#pragma unroll
        for (int t = 0; t < 9; ++t) {
            const LAS bf16_t* kp = Ks + (16 * (qs + t) + qi) * SA_KLD + 8 * g;
            const bf16x8 a0 = *(const LAS bf16x8*)kp, a1 = *(const LAS bf16x8*)(kp + 32);
            f32x4 acc = (f32x4){0.f, 0.f, 0.f, 0.f};
            acc = MFMA16(a0, qf0, acc); acc = MFMA16(a1, qf1, acc); s[t] = acc;
            if ((t % 3) == 2) __builtin_amdgcn_sched_barrier(0);
        }
        float mx = sink;
        const int i = 16 * qs + qi;
#pragma unroll
        for (int t = 0; t < 9; ++t)
#pragma unroll
            for (int r = 0; r < 4; ++r) {
                const int j = 16 * (qs + t) + 4 * g + r;
                const bool valid = (j > i) && (j <= i + 128) && (blk > 0 || j >= 128);
                const float v = valid ? s[t][r] * 0.125f : -1e30f; s[t][r] = v; mx = fmaxf(mx, v);
            }
        mx = fmaxf(mx, __shfl_xor(mx, 16)); mx = fmaxf(mx, __shfl_xor(mx, 32));
        float l = 0.f;
#pragma unroll
        for (int t = 0; t < 9; ++t)
#pragma unroll
            for (int r = 0; r < 4; ++r) { const float e = __expf(s[t][r] - mx); s[t][r] = e; l += e; }
        l += __shfl_xor(l, 16); l += __shfl_xor(l, 32); l += __expf(sink - mx);
        const float inv = 1.0f / l;
        bf16x8 pf[5];
#pragma unroll
        for (int s5 = 0; s5 < 5; ++s5) {
            u32x4 w; w.x = cvt_pk_bf16(s[2 * s5][0], s[2 * s5][1]); w.y = cvt_pk_bf16(s[2 * s5][2], s[2 * s5][3]);
            if (2 * s5 + 1 < 9) { w.z = cvt_pk_bf16(s[(2 * s5 + 1) % 9][0], s[(2 * s5 + 1) % 9][1]); w.w = cvt_pk_bf16(s[(2 * s5 + 1) % 9][2], s[(2 * s5 + 1) % 9][3]); } else { w.z = 0u; w.w = 0u; }
            pf[s5] = __builtin_bit_cast(bf16x8, w);
        }
#pragma unroll
        for (int dt = 0; dt < 4; ++dt) {
            f32x4 acc = (f32x4){0.f, 0.f, 0.f, 0.f};
#pragma unroll
            for (int s5 = 0; s5 < 5; ++s5) {
                const LAS bf16_t* vp = Vt + (16 * dt + qi) * SA_VLD + 16 * (qs + 2 * s5) + 4 * g;
                const s16x4 lo = *(const LAS s16x4*)vp, hi = *(const LAS s16x4*)(vp + 16);
                const bf16x8 a = __builtin_shufflevector(lo, hi, 0, 1, 2, 3, 4, 5, 6, 7);
                acc = MFMA16(a, pf[s5], acc);
            }
            u32x2 w; w.x = cvt_pk_bf16(acc[0] * inv, acc[1] * inv); w.y = cvt_pk_bf16(acc[2] * inv, acc[3] * inv);
            *(GAS u32x2*)((GAS bf16_t*)cat + (size_t)row * DM + hq * 64 + 16 * dt + 4 * g) = w;
            __builtin_amdgcn_sched_barrier(0);
        }
    }
    __syncthreads();
}

constexpr int SG_LD = 136;
__device__ __forceinline__ void sgu_unit(LAS unsigned char* lds, const bf16_t* z, bf16_t* cat, const f32x2* sst, const bf16_t* wsgu, const float* ln_g, const float* ln_b, const float* b_s,
                                         int unit, int tid, int wid, int lane) {
    const int grp = unit & 7, chunk = (unit >> 3) & 31, b = unit >> 8;
    const int tb = b * SEQ + chunk * 128;
    LAS bf16_t* Vt = (LAS bf16_t*)lds;
    LAS bf16_t* Wl = (LAS bf16_t*)(lds + 128 * SG_LD * 2);
    LAS float* mu = (LAS float*)(lds + 2 * 128 * SG_LD * 2); LAS float* rs = mu + 128;
    const GAS bf16_t* zg = (const GAS bf16_t*)z;
    if (tid < 128) {
        float s1 = 0.f, s2 = 0.f;
#pragma unroll
        for (int p = 0; p < 16; ++p) { const f32x2 v = ((const GAS f32x2*)sst)[(size_t)p * MTOK + tb + tid]; s1 += v.x; s2 += v.y; }
        const float m = s1 * (1.0f / 1024.0f); const float var = fmaxf(s2 * (1.0f / 1024.0f) - m * m, 0.f);
        mu[tid] = m; rs[tid] = rsqrtf(var + EPS);
    }
    __syncthreads();
    {
        const int ch = tid & 15;
        u32x4 vva[4], wwa[4];
#pragma unroll
        for (int c = 0; c < 4; ++c) {
            const int idx = tid + 512 * c, j = idx >> 4;
            vva[c] = *(const GAS u32x4*)(zg + (size_t)(tb + j) * INW + 2304 + grp * 128 + ch * 8);
            wwa[c] = *(const GAS u32x4*)((const GAS bf16_t*)wsgu + (size_t)grp * 16384 + j * 128 + ch * 8);
        }
        const GAS float* lg = (const GAS float*)ln_g + grp * 128 + ch * 8; const GAS float* lb = (const GAS float*)ln_b + grp * 128 + ch * 8;
        const f32x4 lg0 = *(const GAS f32x4*)lg, lg1 = *(const GAS f32x4*)(lg + 4), lb0 = *(const GAS f32x4*)lb, lb1 = *(const GAS f32x4*)(lb + 4);
        const float lgv[8] = {lg0[0], lg0[1], lg0[2], lg0[3], lg1[0], lg1[1], lg1[2], lg1[3]}, lbv[8] = {lb0[0], lb0[1], lb0[2], lb0[3], lb1[0], lb1[1], lb1[2], lb1[3]};
        asm volatile("" ::: "memory");
#pragma unroll
        for (int c = 0; c < 4; ++c) {
            const int idx = tid + 512 * c, j = idx >> 4;
            const float m = mu[j], r = rs[j];
#pragma unroll
            for (int p = 0; p < 4; ++p) {
                const float v0 = (bflo(vva[c][p]) - m) * r * lgv[2 * p] + lbv[2 * p], v1 = (bfhi(vva[c][p]) - m) * r * lgv[2 * p + 1] + lbv[2 * p + 1];
                const unsigned w = cvt_pk_bf16(v0, v1);
                Vt[(ch * 8 + 2 * p) * SG_LD + j] = (bf16_t)(w & 0xffffu); Vt[(ch * 8 + 2 * p + 1) * SG_LD + j] = (bf16_t)(w >> 16);
            }
            *(LAS u32x4*)(Wl + j * SG_LD + ch * 8) = wwa[c];
        }
    }
    __syncthreads();
    const int li = lane & 15, g = lane >> 4;
    u32x2 uuv[8]; float biasv[8];
#pragma unroll
    for (int it = 0; it < 8; ++it) {
        uuv[it] = *(const GAS u32x2*)(zg + (size_t)(tb + 16 * it + li) * INW + 1280 + grp * 128 + 16 * wid + 4 * g);
        biasv[it] = ((const GAS float*)b_s)[grp * 128 + 16 * it + li];
    }
#pragma unroll
    for (int it = 0; it < 8; ++it) {
        f32x4 acc = (f32x4){0.f, 0.f, 0.f, 0.f};
#pragma unroll
        for (int ks = 0; ks < 4; ++ks) {
            if (32 * ks <= 16 * it + 15) {
                const bf16x8 a = *(const LAS bf16x8*)(Vt + (16 * wid + li) * SG_LD + 32 * ks + 8 * g);
                const bf16x8 bb = *(const LAS bf16x8*)(Wl + (16 * it + li) * SG_LD + 32 * ks + 8 * g);
                acc = MFMA16(a, bb, acc);
            }
        }
        const int tok = tb + 16 * it + li; const int c0 = grp * 128 + 16 * wid + 4 * g;
        const float bias = biasv[it];
        const u32x2 uu = uuv[it];
        u32x2 w; w.x = cvt_pk_bf16(bflo(uu.x) * (acc[0] + bias), bfhi(uu.x) * (acc[1] + bias)); w.y = cvt_pk_bf16(bflo(uu.y) * (acc[2] + bias), bfhi(uu.y) * (acc[3] + bias));
        *(GAS u32x2*)((GAS bf16_t*)cat + (size_t)tok * DM + 1024 + c0) = w;
    }
    __syncthreads();
}

constexpr int XA_KLD = 136, XA_VLD = 264;
__device__ __forceinline__ void xattn_unit(LAS unsigned char* lds, const bf16_t* q, const bf16_t* kv, bf16_t* o, int unit, int tid, int wid, int lane) {
    const int qb = unit & 15, head = (unit >> 4) & 3, b = unit >> 6;
    LAS bf16_t* Kc = (LAS bf16_t*)lds;
    LAS bf16_t* Vt = (LAS bf16_t*)(lds + 256 * XA_KLD * 2);
    const GAS bf16_t* kvg = (const GAS bf16_t*)kv;
    {
        u32x4 kka[8], vva[8];
#pragma unroll
        for (int c = 0; c < 8; ++c) {
            const int idx = tid + 512 * c, key = idx >> 4, ch = idx & 15;
            const GAS bf16_t* kr = kvg + (size_t)(b * 256 + key) * 1024 + head * 128 + ch * 8;
            kka[c] = *(const GAS u32x4*)kr; vva[c] = *(const GAS u32x4*)(kr + 512);
        }
        asm volatile("" ::: "memory");
#pragma unroll
        for (int c = 0; c < 8; ++c) {
            const int idx = tid + 512 * c, key = idx >> 4, ch = idx & 15;
            *(LAS u32x4*)(Kc + key * XA_KLD + ch * 8) = kka[c];
#pragma unroll
            for (int p = 0; p < 4; ++p) { Vt[(ch * 8 + 2 * p) * XA_VLD + key] = (bf16_t)(vva[c][p] & 0xffffu); Vt[(ch * 8 + 2 * p + 1) * XA_VLD + key] = (bf16_t)(vva[c][p] >> 16); }
        }
    }
    __syncthreads();
    const int qi = lane & 15, g = lane >> 4;
    for (int sb = 0; sb < 2; ++sb) {
        const int row = b * SEQ + qb * 256 + wid * 32 + sb * 16 + qi;
        const GAS bf16_t* qr = (const GAS bf16_t*)q + (size_t)row * 512 + head * 128 + 8 * g;
        bf16x8 qf[4];
#pragma unroll
        for (int ks = 0; ks < 4; ++ks) qf[ks] = __builtin_bit_cast(bf16x8, *(const GAS u32x4*)(qr + 32 * ks));
        f32x4 s[16];
#pragma unroll
        for (int kt = 0; kt < 16; ++kt) {
            f32x4 acc = (f32x4){0.f, 0.f, 0.f, 0.f};
#pragma unroll
            for (int ks = 0; ks < 4; ++ks) { const bf16x8 a = *(const LAS bf16x8*)(Kc + (16 * kt + qi) * XA_KLD + 32 * ks + 8 * g); acc = MFMA16(a, qf[ks], acc); }
            s[kt] = acc * 0.08838834764831845f;
            if (kt & 1) __builtin_amdgcn_sched_barrier(0);
        }
        float mx = -1e30f;
#pragma unroll
        for (int kt = 0; kt < 16; ++kt) mx = fmaxf(fmaxf(mx, fmaxf(s[kt][0], s[kt][1])), fmaxf(s[kt][2], s[kt][3]));
        mx = fmaxf(mx, __shfl_xor(mx, 16)); mx = fmaxf(mx, __shfl_xor(mx, 32));
        float l = 0.f;
#pragma unroll
        for (int kt = 0; kt < 16; ++kt)
#pragma unroll
            for (int r = 0; r < 4; ++r) { const float e = __expf(s[kt][r] - mx); s[kt][r] = e; l += e; }
        l += __shfl_xor(l, 16); l += __shfl_xor(l, 32);
        const float inv = 1.0f / l;
        bf16x8 pf[8];
#pragma unroll
        for (int s8 = 0; s8 < 8; ++s8) {
            u32x4 w; w.x = cvt_pk_bf16(s[2 * s8][0], s[2 * s8][1]); w.y = cvt_pk_bf16(s[2 * s8][2], s[2 * s8][3]);
            w.z = cvt_pk_bf16(s[2 * s8 + 1][0], s[2 * s8 + 1][1]); w.w = cvt_pk_bf16(s[2 * s8 + 1][2], s[2 * s8 + 1][3]);
            pf[s8] = __builtin_bit_cast(bf16x8, w);
        }
#pragma unroll
        for (int dt = 0; dt < 8; ++dt) {
            f32x4 acc = (f32x4){0.f, 0.f, 0.f, 0.f};
#pragma unroll
            for (int s8 = 0; s8 < 8; ++s8) {
                const LAS bf16_t* vp = Vt + (16 * dt + qi) * XA_VLD + 32 * s8 + 4 * g;
                const s16x4 lo = *(const LAS s16x4*)vp, hi = *(const LAS s16x4*)(vp + 16);
                const bf16x8 a = __builtin_shufflevector(lo, hi, 0, 1, 2, 3, 4, 5, 6, 7);
                acc = MFMA16(a, pf[s8], acc);
            }
            u32x2 w; w.x = cvt_pk_bf16(acc[0] * inv, acc[1] * inv); w.y = cvt_pk_bf16(acc[2] * inv, acc[3] * inv);
            *(GAS u32x2*)((GAS bf16_t*)o + (size_t)row * 512 + head * 128 + 16 * dt + 4 * g) = w;
            __builtin_amdgcn_sched_barrier(0);
        }
    }
    __syncthreads();
}

template <int W>
__device__ __forceinline__ void pool_body(const LAS float* R, const GAS bf16_t* hg, const f32x4 gv, GAS bf16_t* pg, int t0, int s0) {
    constexpr int NR = W - 1 + 32;
    u32x2 v[NR];
#pragma unroll
    for (int k = 0; k < NR; ++k) { const int tok = t0 - (W - 1) + k; v[k] = *(const GAS u32x2*)(hg + (size_t)(tok < 0 ? 0 : tok) * DM); }
    f32x4 sum = (f32x4){0.f, 0.f, 0.f, 0.f};
#pragma unroll
    for (int k = 0; k < W - 1; ++k) { const float r = R[16 - W + k]; sum += (f32x4){bflo(v[k].x), bfhi(v[k].x), bflo(v[k].y), bfhi(v[k].y)} * r; }
#pragma unroll
    for (int i = 0; i < 32; ++i) {
        const float r = R[15 + i];
        const f32x4 cur = (f32x4){bflo(v[W - 1 + i].x), bfhi(v[W - 1 + i].x), bflo(v[W - 1 + i].y), bfhi(v[W - 1 + i].y)} * r;
        const int cnt = (s0 + i + 1) < W ? (s0 + i + 1) : W;
        const float ic = 1.0f / (float)cnt;
        sum += cur;
        const f32x4 o = (sum * ic - cur) * gv;
        u32x2 wv; wv.x = cvt_pk_bf16(o[0], o[1]); wv.y = cvt_pk_bf16(o[2], o[3]);
        *(GAS u32x2*)(pg + (size_t)(t0 + i) * DM) = wv;
        const float ro = R[15 + i - (W - 1)];
        sum -= (f32x4){bflo(v[i].x), bfhi(v[i].x), bflo(v[i].y), bfhi(v[i].y)} * ro;
    }
}
__device__ __forceinline__ void pool_unit(LAS unsigned char* lds, const bf16_t* xb, const float* rs, const float* gpre, bf16_t* pooled, int unit, int tid) {
    LAS float* R = (LAS float*)lds;
    const int t0 = unit * 32, s0 = t0 & (SEQ - 1);
    if (tid < 47) { const int tok = t0 - 15 + tid; R[tid] = ((s0 - 15 + tid) >= 0) ? row_rs(rs, tok) : 0.f; }
    __syncthreads();
    const int c0 = tid * 4;
    const GAS bf16_t* hg = (const GAS bf16_t*)xb + c0; GAS bf16_t* pg = (GAS bf16_t*)pooled + c0;
    const f32x4 gv = *(const GAS f32x4*)((const GAS float*)gpre + c0);
    const int grp = __builtin_amdgcn_readfirstlane(c0 >> 9);
    if (grp == 0) pool_body<2>(R, hg, gv, pg, t0, s0);
    else if (grp == 1) pool_body<4>(R, hg, gv, pg, t0, s0);
    else if (grp == 2) pool_body<8>(R, hg, gv, pg, t0, s0);
    else pool_body<16>(R, hg, gv, pg, t0, s0);
    __syncthreads();
}

#define XB_TMO      128
#define XB_XCNT(j)  (256  + 64 * (j))
#define XB_XSUB(j)  (1280 + 64 * (j))
#define XB_XGEN(j)  (2304 + 64 * (j))
#define XB_TOP      3328
#define XB_TOPGEN   3392
#define XCD_BAR_WORDS 3456
#define XB_SPIN_CAP (1u << 22)
__device__ __forceinline__ unsigned xb_ld(unsigned* p)              { return __hip_atomic_load(p, __ATOMIC_RELAXED, __HIP_MEMORY_SCOPE_AGENT); }
__device__ __forceinline__ unsigned xb_add(unsigned* p, unsigned v) { return __hip_atomic_fetch_add(p, v, __ATOMIC_RELAXED, __HIP_MEMORY_SCOPE_AGENT); }
__device__ __forceinline__ unsigned xb_xcc_id() { return (unsigned)__builtin_amdgcn_s_getreg((3 << 11) | 20) & 0xFu; }
#define XB_SPIN(cond, bar) do { unsigned _sp = 0; while (cond) { __builtin_amdgcn_s_sleep(1); \
    if ((++_sp & 255u) == 0u) { if (xb_ld(&(bar)[XB_TMO])) break; if (_sp > XB_SPIN_CAP) { atomicAdd(&(bar)[XB_TMO], 1u); break; } } } } while (0)
struct XcdBarrier { unsigned* bar; unsigned x; volatile LAS unsigned* st; };
__device__ __forceinline__ XcdBarrier xcd_barrier_post(unsigned* bar, volatile LAS unsigned* st) {
    XcdBarrier b; b.bar = bar; b.x = xb_xcc_id(); b.st = st;
    if (threadIdx.x == 0) (void)xb_add(&bar[XB_XCNT(b.x)], 1u);
    return b;
}
__device__ __forceinline__ void xcd_barrier_complete(unsigned* bar, unsigned x, unsigned& nloc, unsigned& nx) {
    const unsigned G = gridDim.x * gridDim.y * gridDim.z;
    unsigned sum, cnt, mine, sp = 0u;
    for (;;) {
        sum = 0u; cnt = 0u; mine = 0u;
#pragma unroll
        for (unsigned j = 0; j < 16; ++j) { const unsigned c = xb_ld(&bar[XB_XCNT(j)]); sum += c; cnt += (c > 0u) ? 1u : 0u; mine = (j == x) ? c : mine; }
        if (sum == G) break;
        __builtin_amdgcn_s_sleep(1);
        if ((++sp & 255u) == 0u) { if (xb_ld(&bar[XB_TMO])) break; if (sp > XB_SPIN_CAP) { atomicAdd(&bar[XB_TMO], 1u); break; } }
    }
    nloc = mine > 0u ? mine : 1u; nx = cnt > 0u ? cnt : 1u;
}
__device__ __forceinline__ void xcd_barrier(const XcdBarrier& b) {
    asm volatile("s_waitcnt vmcnt(0)" ::: "memory");
    __syncthreads();
    if (threadIdx.x == 0) {
        unsigned* bar = b.bar;
        __builtin_amdgcn_s_waitcnt(0);
        unsigned nloc = b.st[0], nx = b.st[1];
        if (nloc == 0u) { xcd_barrier_complete(bar, b.x, nloc, nx); b.st[0] = nloc; b.st[1] = nx; }
        const unsigned old = xb_add(&bar[XB_XSUB(b.x)], 1u);
        const unsigned gen = old / nloc;
        if (old + 1u == (gen + 1u) * nloc) {
            __builtin_amdgcn_fence(__ATOMIC_RELEASE, "agent");
            asm volatile("s_waitcnt vmcnt(0)" ::: "memory");
            const unsigned og = xb_add(&bar[XB_TOP], 1u);
            const unsigned tg = og / nx;
            if (og + 1u == (tg + 1u) * nx) xb_add(&bar[XB_TOPGEN], 1u);
            else XB_SPIN(xb_ld(&bar[XB_TOPGEN]) == tg, bar);
            __builtin_amdgcn_fence(__ATOMIC_ACQUIRE, "agent");
            xb_add(&bar[XB_XGEN(b.x)], 1u);
            asm volatile("s_waitcnt vmcnt(0)" ::: "memory");
        } else {
            XB_SPIN(xb_ld(&bar[XB_XGEN(b.x)]) == gen, bar);
            __builtin_amdgcn_fence(__ATOMIC_ACQUIRE, "agent");
            asm volatile("s_waitcnt vmcnt(0)" ::: "memory");
        }
    }
    __syncthreads();
}

template <class Sched>
__device__ __forceinline__ void fill_rs_table(LAS float* T, const float* rsp, const Sched& S, int tid) {
    const int half = __builtin_amdgcn_readfirstlane(tid >> 8), lt = tid & 255;
    f32x4 a[8], b[8]; bool ok[8];
#pragma unroll
    for (int j = 0; j < 8; ++j) {
        pg8::Unit u; const int i = 2 * j + half;
        ok[j] = (i < RS_TABLE_UNITS) && S.next(i, u);
        const int pm = ok[j] ? u.pm : 0;
        const GAS float* p = (const GAS float*)rsp + ((size_t)pm * 256 + lt) * 8;
        a[j] = *(const GAS f32x4*)p; b[j] = *(const GAS f32x4*)(p + 4);
    }
#pragma unroll
    for (int j = 0; j < 8; ++j)
        if (ok[j]) T[(2 * j + half) * 256 + lt] = __builtin_amdgcn_rsqf((((a[j][0] + a[j][1]) + (a[j][2] + a[j][3])) + ((b[j][0] + b[j][1]) + (b[j][2] + b[j][3]))) * (1.0f / DM) + EPS);
    __syncthreads();
}

struct Args { const float* in[23]; float* out; unsigned char* ws; float inv[8]; int ph_lo, ph_hi; };

struct ConvJob { const float* W; bf16_t* WT; const float* scale; const float* kscale; int K, N, mode, roff, item; };
constexpr int CI_FF = (DM / 64) * (DFF / 32), CI_Q = (DM / 64) * (512 / 32), CI_WO = (512 / 64) * (DM / 32), CI_IN = (DM / 64) * (INW / 32), CI_OUT = (DM / 64) * (DM / 32), CI_PL = (512 / 64) * (512 / 32);
constexpr int CI_COMMON = 6 * CI_FF + 3 * CI_Q + CI_WO, CI_L0 = CI_COMMON + CI_IN + CI_OUT, CI_L1 = CI_COMMON + 4 * CI_PL;
__device__ __forceinline__ ConvJob conv_decode(const Args& a, int r) {
    int layer = 0; if (r >= CI_L0) { layer = 1; r -= CI_L0; }
    unsigned char* ws = a.ws + WS_WL + (size_t)layer * WL_STRIDE;
    const size_t FW = (size_t)DM * DFF;
    const float* nb = a.in[2] + (size_t)layer * 8 * DM;
    ConvJob j; j.scale = nullptr; j.kscale = nullptr; j.mode = 0; j.roff = 0; j.K = DM; j.N = DFF;
    if (r < CI_FF) { j.W = a.in[4] + layer * FW; j.WT = (bf16_t*)(ws + WO_W1A); j.mode = 1; j.kscale = nb; j.item = r; return j; } r -= CI_FF;
    if (r < CI_FF) { j.W = a.in[5] + layer * FW; j.WT = (bf16_t*)(ws + WO_W1A); j.mode = 2; j.kscale = nb; j.item = r; return j; } r -= CI_FF;
    if (r < CI_FF) { j.W = a.in[6] + layer * FW; j.WT = (bf16_t*)(ws + WO_W1D); j.K = DFF; j.N = DM; j.item = r; return j; } r -= CI_FF;
    if (r < CI_FF) { j.W = a.in[7] + layer * FW; j.WT = (bf16_t*)(ws + WO_W2A); j.mode = 1; j.kscale = nb + 6 * DM; j.item = r; return j; } r -= CI_FF;
    if (r < CI_FF) { j.W = a.in[8] + layer * FW; j.WT = (bf16_t*)(ws + WO_W2A); j.mode = 2; j.kscale = nb + 6 * DM; j.item = r; return j; } r -= CI_FF;
    if (r < CI_FF) { j.W = a.in[9] + layer * FW; j.WT = (bf16_t*)(ws + WO_W2D); j.K = DFF; j.N = DM; j.item = r; return j; } r -= CI_FF;
    j.N = 512;
    if (r < CI_Q) { j.W = a.in[10] + (size_t)layer * DM * 512; j.WT = (bf16_t*)(ws + WO_WQ); j.kscale = nb + 4 * DM; j.item = r; return j; } r -= CI_Q;
    if (r < CI_Q) { j.W = a.in[11] + (size_t)layer * DM * 512; j.WT = (bf16_t*)(ws + WO_WKV); j.item = r; return j; } r -= CI_Q;
    if (r < CI_Q) { j.W = a.in[12] + (size_t)layer * DM * 512; j.WT = (bf16_t*)(ws + WO_WKV); j.roff = 512; j.item = r; return j; } r -= CI_Q;
    if (r < CI_WO) { j.W = a.in[13] + (size_t)layer * 512 * DM; j.WT = (bf16_t*)(ws + WO_WO); j.K = 512; j.N = DM; j.item = r; return j; } r -= CI_WO;
    if (layer == 0) {
        if (r < CI_IN) { j.W = a.in[14]; j.WT = (bf16_t*)(ws + WO_WIN); j.N = INW; j.kscale = nb + 2 * DM; j.item = r; return j; } r -= CI_IN;
        j.W = a.in[15]; j.WT = (bf16_t*)(ws + WO_WOUT); j.N = DM; j.item = r; return j;
    }
    const int gi = r / CI_PL; r -= gi * CI_PL;
    j.W = a.in[21] + (size_t)gi * 512 * 512; j.WT = (bf16_t*)(ws + WO_WPOOL); j.K = 512; j.N = 512; j.roff = gi * 512; j.scale = a.in[22] + gi * 512; j.item = r; return j;
}
__device__ __forceinline__ void conv_load(const ConvJob& j, int lane, float (&v)[32]) {
    const int nblk = j.N / 32, kb = j.item / nblk, nb = j.item % nblk;
    const GAS float* Wg = (const GAS float*)j.W + (size_t)(64 * kb + (lane >> 5)) * j.N + 32 * nb + (lane & 31);
#pragma unroll
    for (int i = 0; i < 32; ++i) v[i] = Wg[(size_t)(2 * i) * j.N];
}
__device__ __forceinline__ void conv_finish(const ConvJob& j, LAS float* scr, int lane, const float (&v)[32]) {
    const int nblk = j.N / 32, kb = j.item / nblk, nb = j.item % nblk, k0 = 64 * kb, n0 = 32 * nb;
    const float sc = j.scale ? ((const GAS float*)j.scale)[n0 + (lane & 31)] : 1.0f;
#pragma unroll
    for (int i = 0; i < 32; ++i) scr[(2 * i + (lane >> 5)) * 33 + (lane & 31)] = v[i] * sc;
    asm volatile("s_waitcnt lgkmcnt(0)" ::: "memory");
    const int drow0 = (j.mode == 0) ? (j.roff + n0) : (256 * (n0 >> 7) + (n0 & 127) + (j.mode == 2 ? 128 : 0));
    const int c = lane & 7;
    f32x4 ka = (f32x4){1.f, 1.f, 1.f, 1.f}, kc = ka;
    if (j.kscale) { ka = *(const GAS f32x4*)((const GAS float*)j.kscale + k0 + 8 * c); kc = *(const GAS f32x4*)((const GAS float*)j.kscale + k0 + 8 * c + 4); }
#pragma unroll
    for (int q = 0; q < 4; ++q) { const int n = (lane >> 3) + 8 * q; const LAS float* s = scr + (8 * c) * 33 + n;
        u32x4 o; o.x = cvt_pk_bf16(s[0 * 33] * ka[0], s[1 * 33] * ka[1]); o.y = cvt_pk_bf16(s[2 * 33] * ka[2], s[3 * 33] * ka[3]); o.z = cvt_pk_bf16(s[4 * 33] * kc[0], s[5 * 33] * kc[1]); o.w = cvt_pk_bf16(s[6 * 33] * kc[2], s[7 * 33] * kc[3]);
        *(GAS u32x4*)((GAS bf16_t*)j.WT + (size_t)(drow0 + n) * j.K + k0 + 8 * c) = o; }
    asm volatile("s_waitcnt lgkmcnt(0)" ::: "memory");
}
__device__ __forceinline__ void conv_all(const Args& a, LAS unsigned char* lds, int wid, int lane, int gw, int ngw) {
    LAS float* scr = (LAS float*)(lds + wid * 16384);
    constexpr int NT = CI_L0 + CI_L1;
    for (int it = gw; it < NT; it += 2 * ngw) {
        const bool h1 = (it + ngw) < NT;
        const ConvJob j0 = conv_decode(a, it), j1 = conv_decode(a, h1 ? it + ngw : it);
        float v0[32], v1[32];
        conv_load(j0, lane, v0); conv_load(j1, lane, v1);
        asm volatile("" ::: "memory");
        conv_finish(j0, scr, lane, v0);
        if (h1) conv_finish(j1, scr, lane, v1);
    }
    for (int layer = 0; layer < 2; ++layer)
        norm_pass(a.in[1], nullptr, nullptr, nullptr, 0.f, nullptr, a.in[3] + layer * DM, (bf16_t*)(a.ws + WS_MEMN + (size_t)layer * 4 * MiB), MEMROWS, gw, ngw, lane);
}

__global__ void __launch_bounds__(512, 2) mega_fwd(Args a) {
    extern __shared__ __attribute__((aligned(16))) unsigned char lds_raw[];
    LAS unsigned char* lds = (LAS unsigned char*)lds_raw;
    cg::grid_group grid = cg::this_grid();
    const int tid = threadIdx.x, lane = tid & 63, wid = __builtin_amdgcn_readfirstlane(tid >> 6);
    const int G = gridDim.x, bx = blockIdx.x;
    const int gw = bx * 8 + wid, ngw = G * 8;
    unsigned char* ws = a.ws;
    bf16_t* Hb = (bf16_t*)(ws + WS_H); float* RS = (float*)(ws + WS_RS);
    bf16_t* HID = (bf16_t*)(ws + WS_HID); bf16_t* Zb = (bf16_t*)(ws + WS_Z); bf16_t* CAT = (bf16_t*)(ws + WS_CAT); bf16_t* POOLB = (bf16_t*)(ws + WS_POOL);
    bf16_t* Qb = (bf16_t*)(ws + WS_Q); bf16_t* Ob = (bf16_t*)(ws + WS_O);
    f32x2* rope = (f32x2*)(ws + WS_ROPE); f32x2* sst = (f32x2*)(ws + WS_SST); bf16_t* SGUW = (bf16_t*)(ws + WS_SGUW);
    const float* norms = a.in[2];
    const int lo = a.ph_lo, hi = a.ph_hi;
    int gp = 0;
    volatile LAS unsigned* MISC = (volatile LAS unsigned*)(lds + LDS_BYTES - 64);
    if (tid < 16) MISC[tid] = 0u;
    __syncthreads();
    XcdBarrier xbar = xcd_barrier_post((unsigned*)ws, MISC);
#define SEAM() do { if (gp + 1 < hi) { if (a.inv[0] < 0.f) grid.sync(); else xcd_barrier(xbar); } } while (0)
#define SEAM_X() do { if (gp + 1 < hi) xcd_barrier(xbar); } while (0)

    if (gp >= lo && gp < hi) {
        prep_pass(a.in[0], Hb, RS, MTOK, gw, ngw, lane);
        conv_all(a, lds, wid, lane, gw, ngw);
        for (int idx = bx * 512 + tid; idx < SEQ * 8; idx += G * 512) {
            const int pos = idx >> 3, k = idx & 7;
            const float ang = (float)pos * a.inv[k];
            double rev = (double)ang * 0.15915494309189535; rev -= floor(rev);
            const float fr = (float)rev;
            ((GAS f32x2*)rope)[idx] = (f32x2){__builtin_amdgcn_cosf(fr), __builtin_amdgcn_sinf(fr)};
        }
        for (int idx = bx * 512 + tid; idx < MTOK * 8; idx += G * 512) ((GAS unsigned long long*)(ws + WS_XB))[idx] = 0ull;
        for (int idx = bx * 512 + tid; idx < 8 * 128 * 128; idx += G * 512) {
            const int i = (idx >> 7) & 127, j = idx & 127;
            const float v = (j <= i) ? ((const GAS float*)a.in[19])[idx] : 0.f;
            ((GAS bf16_t*)SGUW)[idx] = (bf16_t)(cvt_pk_bf16(v, 0.f) & 0xffffu);
        }
        SEAM();
    }
    ++gp;

#pragma unroll 1
    for (int layer = 0; layer < 2; ++layer) {
        const float* gl = norms + layer * 8 * DM;
        const unsigned char* wl = ws + WS_WL + (size_t)layer * WL_STRIDE;
#pragma unroll 1
        for (int p = 0; p < 10; ++p) {
            if ((layer == 1 && p == 3) || p == 6) continue;
            if (gp >= lo && gp < hi) {
                const int tid = fresh_tid(), lane = tid & 63, wid = __builtin_amdgcn_readfirstlane(tid >> 6);
                if (p == 0 || p == 8) {
                    pg8::Gemm g{Hb, (const bf16_t*)(wl + (p == 0 ? WO_W1A : WO_W2A)), MTOK, 2 * DFF, DM, DM, DM, 0, 0u};
                    pg8::StaticOrder S; S.init(MTOK, 2 * DFF, G, bx);
                    fill_rs_table((LAS float*)(lds + XL_OFF), RS, S, tid);
                    pg8::EpiSwiglu E{HID, RS, (const LAS float*)(lds + XL_OFF)};
                    pg8::gemm_phase<pg8::EpiSwiglu, pg8::StaticOrder>(lds, g, S, E);
                } else if (p == 1 || p == 9 || p == 4 || p == 7) {
                    pg8::Gemm g;
                    if (p == 1 || p == 9) g = pg8::Gemm{HID, (const bf16_t*)(wl + (p == 1 ? WO_W1D : WO_W2D)), MTOK, DM, DFF, DFF, DFF, 0, 0u};
                    else if (p == 7) g = pg8::Gemm{Ob, (const bf16_t*)(wl + WO_WO), MTOK, DM, 512, 512, 512, 0, 0u};
                    else if (layer == 0) g = pg8::Gemm{CAT, (const bf16_t*)(wl + WO_WOUT), MTOK, DM, DM, DM, DM, 0, 0u};
                    else g = pg8::Gemm{POOLB, (const bf16_t*)(wl + WO_WPOOL), MTOK, DM, 512, DM, 512, 1, 1024u};
                    const int gi = (p == 1) ? 1 : (p == 4) ? 3 : (p == 7) ? 5 : 7;
                    const int seq = layer * 4 + (gi >> 1);
                    const bool final_ = (p == 9 && layer == 1);
                    pg8::PanelOrder S; S.init(MTOK, G, bx);
                    pg8::EpiNorm E{Hb, final_ ? a.out : nullptr, RS, gl + gi * DM, (p == 1 || p == 9) ? 0.5f : 1.0f,
                                   (float*)(ws + WS_XB), (unsigned*)(ws + WS_CNT), (unsigned)(seq + 1), lds + XL_OFF};
                    pg8::gemm_phase<pg8::EpiNorm, pg8::PanelOrder>(lds, g, S, E);
                } else if (p == 2) {
                    if (layer == 0) {
                        pg8::Gemm g{Hb, (const bf16_t*)(wl + WO_WIN), MTOK, INW, DM, DM, DM, 0, 0u};
                        pg8::StaticOrder S; S.init(MTOK, INW, G, bx);
                        fill_rs_table((LAS float*)(lds + XL_OFF), RS, S, tid);
                        pg8::EpiAct E{Zb, INW, 5, 9, sst, RS, (const LAS float*)(lds + XL_OFF)};
                        for (int k = 0; k < 3; ++k) {
                            if (k > 0) {
                                const unsigned char* wk = ws + WS_WL + (size_t)(k - 1) * WL_STRIDE;
                                g = pg8::Gemm{(const bf16_t*)(ws + WS_MEMN + (size_t)(k - 1) * 4 * MiB), (const bf16_t*)(wk + WO_WKV), MEMROWS, 1024, DM, DM, DM, 0, 0u};
                                S.init(MEMROWS, 1024, G, G > 96 ? (bx + G - 64 - 16 * (k - 1)) % G : bx);
                                E = pg8::EpiAct{(bf16_t*)(ws + WS_KV + (size_t)(k - 1) * 2 * MiB), 1024, 1 << 30, 1 << 30, sst, nullptr, nullptr};
                            }
                            pg8::gemm_phase<pg8::EpiAct, pg8::StaticOrder>(lds, g, S, E);
                        }
                    } else {
                        for (int u = bx; u < MTOK / 32; u += G) pool_unit(lds, Hb, RS, gl + 2 * DM, POOLB, u, tid);
                    }
                } else if (p == 3) {
                    for (int u = bx; u < 256 + 1024; u += G) {
                        if (u < 256) attn_unit(lds, Zb, CAT, rope, a.in[16], u, tid, wid, lane);
                        else sgu_unit(lds, Zb, CAT, sst, SGUW, a.in[17], a.in[18], a.in[20], u - 256, tid, wid, lane);
                    }
                } else if (p == 5) {
                    pg8::Gemm g{Hb, (const bf16_t*)(wl + WO_WQ), MTOK, 512, DM, DM, DM, 0, 0u};
                    pg8::StaticOrder S; S.init(MTOK, 1024, G, bx);
                    fill_rs_table((LAS float*)(lds + XL_OFF), RS, S, tid);
                    pg8::EpiHalf E{Qb, 512, RS, (const LAS float*)(lds + XL_OFF)};
                    pg8::gemm_phase<pg8::EpiHalf, pg8::StaticOrder, true>(lds, g, S, E);
                    const bf16_t* kvl = (const bf16_t*)(ws + WS_KV + (size_t)layer * 2 * MiB);
                    pg8::Unit u;
                    for (int i = 0; S.next(i, u); ++i) xattn_unit(lds, Qb, kvl, Ob, ((u.pm >> 4) * 4 + u.pn) * 16 + (u.pm & 15), tid, wid, lane);
                }
                if (!(layer == 1 && p == 9)) SEAM_X();
            }
            ++gp;
        }
    }
#undef SEAM
#undef SEAM_X
}

extern "C" void kernel_launch(void* const* d_in, const int* in_sizes, int n_in, void* d_out, int out_size, void* d_ws, size_t ws_size, hipStream_t stream) {
    static int grid = 0;
    if (grid == 0) {
        if (n_in != 23 || out_size != MTOK * DM || ws_size < WS_END) { fprintf(stderr, "kernel_launch: unexpected problem (n_in %d, out %d, ws %zu)\n", n_in, out_size, ws_size); grid = -1; return; }
        int dev = 0, cus = 0, per_cu = 0;
        hipGetDevice(&dev);
        hipDeviceGetAttribute(&cus, hipDeviceAttributeMultiprocessorCount, dev);
        if (hipFuncSetAttribute((const void*)mega_fwd, hipFuncAttributeMaxDynamicSharedMemorySize, LDS_BYTES) != hipSuccess) { fprintf(stderr, "kernel_launch: hipFuncSetAttribute failed\n"); grid = -1; return; }
        if (hipOccupancyMaxActiveBlocksPerMultiprocessor(&per_cu, (const void*)mega_fwd, 512, LDS_BYTES) != hipSuccess || per_cu < 1) { fprintf(stderr, "kernel_launch: occupancy query gave %d\n", per_cu); per_cu = 1; }
        (void)hipGetLastError();
        grid = cus * per_cu; grid -= grid % 8;
        fprintf(stderr, "kernel_launch: grid %d (cus %d x %d)\n", grid, cus, per_cu);
    }
    if (grid < 0) return;
    if (hipMemsetAsync(d_ws, 0, 65536, stream) != hipSuccess) { fprintf(stderr, "kernel_launch: memset failed\n"); return; }
    Args a{};
    for (int i = 0; i < 23; ++i) a.in[i] = (const float*)d_in[i];
    a.out = (float*)d_out; a.ws = (unsigned char*)d_ws;
    for (int k = 0; k < 8; ++k) a.inv[k] = (float)pow(500000.0, -(double)k / 8.0);
    a.ph_lo = 0; a.ph_hi = 1000;
    void* args[] = {&a};
    hipError_t e = hipLaunchCooperativeKernel((const void*)mega_fwd, dim3(grid), dim3(512), args, LDS_BYTES, stream);
    if (e != hipSuccess) fprintf(stderr, "kernel_launch: cooperative launch failed: %s (grid %d)\n", hipGetErrorString(e), grid);
}
```

```cpp
#include <hip/hip_runtime.h>
#include <hip/hip_cooperative_groups.h>
#include <cstdio>
#include <cstdint>
#include <cmath>
namespace cg = cooperative_groups;

#define LAS __attribute__((address_space(3)))
#define GAS __attribute__((address_space(1)))
typedef unsigned short bf16_t;
typedef short bf16x8 __attribute__((ext_vector_type(8)));
typedef short s16x4 __attribute__((ext_vector_type(4)));
typedef float f32x4 __attribute__((ext_vector_type(4)));
typedef float f32x2 __attribute__((ext_vector_type(2)));
typedef unsigned u32x4 __attribute__((ext_vector_type(4)));
typedef unsigned u32x2 __attribute__((ext_vector_type(2)));

constexpr int MTOK = 16384, DM = 2048, DFF = 5632, SEQ = 4096, MEMROWS = 1024;
constexpr int INW = 3328;
constexpr float EPS = 1e-6f;

constexpr size_t MiB = 1u << 20;
constexpr size_t WS_CNT  = 16384;
constexpr size_t WS_ROPE = 1 * MiB;
constexpr size_t WS_XB   = 2 * MiB;
constexpr size_t WS_RS   = 3 * MiB;
constexpr size_t WS_SST  = 4 * MiB;
constexpr size_t WS_SGUW = 6 * MiB;
constexpr size_t WS_MEMN = 8 * MiB;
constexpr size_t WS_Q    = 16 * MiB;
constexpr size_t WS_O    = 32 * MiB;
constexpr size_t WS_KV   = 48 * MiB;
constexpr size_t WS_H    = 64 * MiB;
constexpr size_t WS_HID  = 128 * MiB;
constexpr size_t WS_Z    = 128 * MiB;
constexpr size_t WS_CAT  = 232 * MiB;
constexpr size_t WS_POOL = 128 * MiB;
constexpr size_t WS_WL   = 304 * MiB;
constexpr size_t WL_STRIDE = 164 * MiB;
constexpr size_t WO_W1A = 0, WO_W1D = 44 * MiB, WO_W2A = 66 * MiB, WO_W2D = 110 * MiB, WO_WQ = 132 * MiB, WO_WKV = 134 * MiB, WO_WO = 138 * MiB,
                 WO_WIN = 140 * MiB, WO_WOUT = 154 * MiB, WO_WPOOL = 140 * MiB;
constexpr size_t WS_END  = WS_WL + 2 * WL_STRIDE;

constexpr int LDS_BYTES = 147456;
constexpr int XL_OFF = 131072;

typedef __bf16 bf16x2_t __attribute__((ext_vector_type(2)));
__device__ __forceinline__ unsigned cvt_pk_bf16(float lo, float hi) { const f32x2 v = {lo, hi}; const bf16x2_t b = __builtin_convertvector(v, bf16x2_t); return __builtin_bit_cast(unsigned, b); }
__device__ __forceinline__ float bflo(unsigned w) { return __uint_as_float(w << 16); }
__device__ __forceinline__ float bfhi(unsigned w) { return __uint_as_float(w & 0xffff0000u); }
__device__ __forceinline__ float wave_sum(float v) {
#pragma unroll
    for (int o = 1; o < 64; o <<= 1) v += __shfl_xor(v, o);
    return v;
}
__device__ __forceinline__ float gelu_tanh(float x) {
    const float inner = 1.5957691216057308f * (x + 0.044715f * x * x * x);
    return x * __builtin_amdgcn_rcpf(1.0f + __expf(-inner));
}
__device__ __forceinline__ float silu_f(float x) { return x * __builtin_amdgcn_rcpf(1.0f + __expf(-x)); }
__device__ __forceinline__ int fresh_tid() { int t = threadIdx.x; asm volatile("" : "+v"(t)); return t; }
__device__ __forceinline__ float row_rs(const float* rsp, int row) {
    const f32x4 a = *(const GAS f32x4*)((const GAS float*)rsp + (size_t)row * 8), b = *(const GAS f32x4*)((const GAS float*)rsp + (size_t)row * 8 + 4);
    return __builtin_amdgcn_rsqf((((a[0] + a[1]) + (a[2] + a[3])) + ((b[0] + b[1]) + (b[2] + b[3]))) * (1.0f / DM) + EPS);
}
constexpr int RS_TABLE_UNITS = 15;
__device__ __forceinline__ float rs_lookup(const LAS float* T, const float* rsp, int ord, int pm, int lrow) {
    return (ord < RS_TABLE_UNITS) ? T[ord * 256 + lrow] : row_rs(rsp, pm * 256 + lrow);
}
__device__ __forceinline__ void rs_lookup8(float (&rsv)[8], const LAS float* T, const float* rsp, int ord, int pm, int lrow0) {
    if (ord < RS_TABLE_UNITS) {
#pragma unroll
        for (int q = 0; q < 8; ++q) rsv[q] = T[ord * 256 + lrow0 + (q >> 2) * 128 + (q & 3) * 16];
    } else {
#pragma unroll
        for (int q = 0; q < 8; ++q) rsv[q] = row_rs(rsp, pm * 256 + lrow0 + (q >> 2) * 128 + (q & 3) * 16);
    }
}
#define MFMA16(a, b, c) __builtin_amdgcn_mfma_f32_16x16x32_bf16((a), (b), (c), 0, 0, 0)

namespace pg8 {
constexpr int BM = 256, BK = 64, HALF = 128, HTB = HALF * BK * 2, STAGE_BYTES = 8 * HTB, NXCD = 8, WGM = 8;
__host__ __device__ __forceinline__ int lds_byte(int r, int c) { const int st = (r >> 4) * 2 + (c >> 5), rr = r & 15, cc = c & 31, ob = rr * 64 + cc * 2; return st * 1024 + (ob ^ (((ob >> 9) & 1) << 5)); }
__host__ __device__ __forceinline__ void stage_rc(int b, int& R, int& C) { const int st = b / 1024, sb = b % 1024, swz = sb ^ (((sb >> 9) & 1) << 5); R = (st >> 1) * 16 + swz / 64; C = (st & 1) * 32 + (swz % 64) / 2; }
__host__ __device__ __forceinline__ int perm32(int rho) { const int n = rho >> 4, i = rho & 15; return 8 * (i >> 2) + 4 * n + (i & 3); }

struct Unit { int pm, pn, ord; };
struct Gemm { const bf16_t* A; const bf16_t* Bt; int M, N, K, lda, ldb, a_shift; unsigned a_stride; };

struct StaticOrder {
    int nM, nN, nwg, G, c;
    __device__ void init(int M, int N, int G_, int c_) { nM = M / BM; nN = N / BM; nwg = nM * nN; G = G_; c = c_; }
    __device__ bool next(int i, Unit& u) const {
        const long L = (long)i * G + c; if (L >= nwg) return false;
        int wgid = (int)L; { const int q = nwg / NXCD, r = nwg % NXCD, xcd = wgid % NXCD, off = wgid / NXCD; wgid = (xcd < r ? xcd * (q + 1) : r * (q + 1) + (xcd - r) * q) + off; }
        const int nig = WGM * nN, gid = wgid / nig, fm = gid * WGM, gsz = (nM - fm) < WGM ? (nM - fm) : WGM;
        u.pm = fm + ((wgid % nig) % gsz); u.pn = (wgid % nig) / gsz; return true;
    }
};


struct EpiAct {
    bf16_t* O; int ldc; int gelu_from, stat_from; f32x2* st;
    const float* rs; const LAS float* T;
    __device__ __forceinline__ void operator()(const f32x4 (&acc)[2][2][4][2], const Unit& u, int wr, int wc, int fr, int fq) const {
        const int row0 = u.pm * BM + wr * 64 + fr, col0 = u.pn * BM + wc * 32 + 8 * fq;
        const bool do_gelu = u.pn >= gelu_from, do_stat = u.pn >= stat_from;
        float rsv8[8], s1a[8], s2a[8];
        if (rs) rs_lookup8(rsv8, T, rs, u.ord, u.pm, wr * 64 + fr);
        else {
#pragma unroll
            for (int q = 0; q < 8; ++q) rsv8[q] = 1.0f;
        }
#pragma unroll
        for (int ai = 0; ai < 2; ++ai)
#pragma unroll
            for (int m = 0; m < 4; ++m) {
                const int row = row0 + ai * HALF + m * 16;
                GAS bf16_t* rowp = (GAS bf16_t*)O + (size_t)row * ldc + col0;
                const float rsv = rsv8[ai * 4 + m];
                float s1 = 0.f, s2 = 0.f;
#pragma unroll
                for (int bj = 0; bj < 2; ++bj) {
                    f32x4 v0 = acc[ai][bj][m][0] * rsv, v1 = acc[ai][bj][m][1] * rsv;
                    if (do_gelu) {
#pragma unroll
                        for (int e = 0; e < 4; ++e) { v0[e] = gelu_tanh(v0[e]); v1[e] = gelu_tanh(v1[e]); }
                    }
                    if (do_stat) {
#pragma unroll
                        for (int e = 0; e < 4; ++e) { s1 += v0[e] + v1[e]; s2 += v0[e] * v0[e] + v1[e] * v1[e]; }
                    }
                    u32x4 w; w.x = cvt_pk_bf16(v0[0], v0[1]); w.y = cvt_pk_bf16(v0[2], v0[3]); w.z = cvt_pk_bf16(v1[0], v1[1]); w.w = cvt_pk_bf16(v1[2], v1[3]);
                    *(GAS u32x4*)(rowp + bj * HALF) = w;
                }
                s1a[ai * 4 + m] = s1; s2a[ai * 4 + m] = s2;
            }
        if (do_stat) {
            float t1[8], t2[8];
#pragma unroll
            for (int r = 0; r < 8; ++r) { t1[r] = __shfl_xor(s1a[r], 16); t2[r] = __shfl_xor(s2a[r], 16); }
#pragma unroll
            for (int r = 0; r < 8; ++r) { s1a[r] += t1[r]; s2a[r] += t2[r]; }
#pragma unroll
            for (int r = 0; r < 8; ++r) { t1[r] = __shfl_xor(s1a[r], 32); t2[r] = __shfl_xor(s2a[r], 32); }
            if (fq == 0) {
#pragma unroll
                for (int r = 0; r < 8; ++r)
                    ((GAS f32x2*)st)[(size_t)((u.pn - stat_from) * 4 + wc) * MTOK + row0 + (r >> 2) * HALF + (r & 3) * 16] = (f32x2){s1a[r] + t1[r], s2a[r] + t2[r]};
            }
        }
    }
};
struct EpiHalf {
    bf16_t* O; int ldc; const float* rs; const LAS float* T;
    __device__ __forceinline__ void operator()(const f32x4 (&acc)[2][2][4][2], const Unit& u, int wr, int wc, int fr, int fq) const {
        const int row0 = u.pm * BM + wr * 64 + fr, col0 = u.pn * HALF + wc * 32 + 8 * fq;
        float rsv8[8];
        rs_lookup8(rsv8, T, rs, u.ord, u.pm, wr * 64 + fr);
#pragma unroll
        for (int ai = 0; ai < 2; ++ai)
#pragma unroll
            for (int m = 0; m < 4; ++m) {
                const int row = row0 + ai * HALF + m * 16;
                const float rsv = rsv8[ai * 4 + m];
                const f32x4 v0 = acc[ai][0][m][0] * rsv, v1 = acc[ai][0][m][1] * rsv;
                u32x4 w; w.x = cvt_pk_bf16(v0[0], v0[1]); w.y = cvt_pk_bf16(v0[2], v0[3]); w.z = cvt_pk_bf16(v1[0], v1[1]); w.w = cvt_pk_bf16(v1[2], v1[3]);
                *(GAS u32x4*)((GAS bf16_t*)O + (size_t)row * ldc + col0) = w;
            }
    }
};
struct EpiSwiglu {
    bf16_t* O; const float* rs; const LAS float* T;
    __device__ __forceinline__ void operator()(const f32x4 (&acc)[2][2][4][2], const Unit& u, int wr, int wc, int fr, int fq) const {
        const int row0 = u.pm * BM + wr * 64 + fr, col0 = u.pn * HALF + wc * 32 + 8 * fq;
        float rsv[8], irs2[8];
        rs_lookup8(rsv, T, rs, u.ord, u.pm, wr * 64 + fr);
#pragma unroll
        for (int q = 0; q < 8; ++q) irs2[q] = __builtin_amdgcn_rcpf(rsv[q] * rsv[q]);
#pragma unroll
        for (int ai = 0; ai < 2; ++ai)
#pragma unroll
            for (int mp = 0; mp < 2; ++mp) {
                f32x2 gg[8], ee[8];
#pragma unroll
                for (int q = 0; q < 8; ++q) {
                    const int m = 2 * mp + (q >> 2), n = (q >> 1) & 1, h2 = q & 1;
                    gg[q] = (f32x2){acc[ai][0][m][n][2 * h2], acc[ai][0][m][n][2 * h2 + 1]};
                    const f32x2 a2 = gg[q] * (rsv[ai * 4 + m] * -1.4426950408889634f);
                    ee[q].x = __builtin_amdgcn_exp2f(a2.x); ee[q].y = __builtin_amdgcn_exp2f(a2.y);
                }
#pragma unroll
                for (int q = 0; q < 8; ++q) { const float ir = irs2[ai * 4 + 2 * mp + (q >> 2)]; const f32x2 d2 = ee[q] * ir + ir;
                    ee[q].x = __builtin_amdgcn_rcpf(d2.x); ee[q].y = __builtin_amdgcn_rcpf(d2.y); }
                u32x4 w[2];
#pragma unroll
                for (int q = 0; q < 8; ++q) {
                    const int m = 2 * mp + (q >> 2), n = (q >> 1) & 1, h2 = q & 1;
                    const f32x2 u2 = {acc[ai][1][m][n][2 * h2], acc[ai][1][m][n][2 * h2 + 1]};
                    const f32x2 o2 = (gg[q] * u2) * ee[q];
                    w[q >> 2][(q & 3)] = cvt_pk_bf16(o2.x, o2.y);
                }
#pragma unroll
                for (int k = 0; k < 2; ++k) *(GAS u32x4*)((GAS bf16_t*)O + (size_t)(row0 + ai * HALF + (2 * mp + k) * 16) * DFF + col0) = w[k];
            }
    }
};
struct PanelOrder {
    int nwg, G, vcu;
    __device__ void init(int M, int G_, int c_) { nwg = (M / BM) * 8; G = G_; vcu = (c_ % 8) * (G_ / 8) + c_ / 8; }
    __device__ bool next(int i, Unit& u) const { const long L = (long)i * G + vcu; if (L >= nwg) return false; u.pm = (int)(L >> 3); u.pn = (int)(L & 7); return true; }
};
struct EpiNorm {
    bf16_t* XB; float* OUT; float* rs; const float* g_post; float wgt;
    float* xb; unsigned* cnt; unsigned want; LAS unsigned char* xl;
    __device__ __forceinline__ void exchange_post(const f32x4 (&v)[2][2][4][2], const Unit& u, int wr, int wc, int fr, int fq, int wid, int lane, int which) const {
        LAS float* P = (LAS float*)xl;
        float q8[8];
#pragma unroll
        for (int ai = 0; ai < 2; ++ai)
#pragma unroll
            for (int m = 0; m < 4; ++m) {
                float q = 0.f;
#pragma unroll
                for (int bj = 0; bj < 2; ++bj)
#pragma unroll
                    for (int n = 0; n < 2; ++n) { const f32x4 x = v[ai][bj][m][n]; q += (x[0] * x[0] + x[1] * x[1]) + (x[2] * x[2] + x[3] * x[3]); }
                q8[ai * 4 + m] = q;
            }
        { float t8[8];
#pragma unroll
          for (int r = 0; r < 8; ++r) t8[r] = __shfl_xor(q8[r], 16);
#pragma unroll
          for (int r = 0; r < 8; ++r) q8[r] += t8[r];
#pragma unroll
          for (int r = 0; r < 8; ++r) t8[r] = __shfl_xor(q8[r], 32);
#pragma unroll
          for (int r = 0; r < 8; ++r) q8[r] += t8[r]; }
        if (fq == 0) {
#pragma unroll
            for (int r = 0; r < 8; ++r) P[((r >> 2) * HALF + wr * 64 + (r & 3) * 16 + fr) * 4 + wc] = q8[r];
        }
        asm volatile("s_waitcnt lgkmcnt(0)" ::: "memory"); __builtin_amdgcn_s_barrier(); asm volatile("" ::: "memory");
        const int row = wid * 32 + (lane & 31);
        unsigned long long* slots = (unsigned long long*)xb + ((size_t)u.pm * BM + row) * 8;
        if (lane < 32) {
            const float t = (P[row * 4 + 0] + P[row * 4 + 1]) + (P[row * 4 + 2] + P[row * 4 + 3]);
            __hip_atomic_store(slots + u.pn, ((unsigned long long)want << 32) | (unsigned long long)__float_as_uint(t), __ATOMIC_RELAXED, __HIP_MEMORY_SCOPE_AGENT);
        }
    }
    __device__ __forceinline__ void exchange_wait(const Unit& u, int wid, int lane, int which, float scale) const {
        LAS float* S = (LAS float*)(xl + 4096);
        const int row = wid * 32 + (lane & 31);
        unsigned long long* slots = (unsigned long long*)xb + ((size_t)u.pm * BM + row) * 8;
        float t = 0.f; bool done = lane >= 32;
        for (unsigned it = 0; it < (1u << 15); ++it) {
            if (!done) {
                bool ok = true; float acc = 0.f;
#pragma unroll
                for (int h4 = 0; h4 < 2; ++h4) {
                    unsigned long long w[4];
#pragma unroll
                    for (int k = 0; k < 4; ++k) w[k] = __hip_atomic_load(slots + 4 * h4 + k, __ATOMIC_RELAXED, __HIP_MEMORY_SCOPE_AGENT);
#pragma unroll
                    for (int k = 0; k < 4; ++k) { ok = ok && ((unsigned)(w[k] >> 32) == want); acc += __uint_as_float((unsigned)w[k]); }
                    asm volatile("" ::: "memory");
                }
                if (ok) { t = acc; done = true; }
            }
            if (!__any(!done)) break;
            __builtin_amdgcn_s_sleep(1);
        }
        if (lane < 32) S[row] = scale * rsqrtf(t * (1.0f / DM) + EPS);
        asm volatile("s_waitcnt vmcnt(0) lgkmcnt(0)" ::: "memory"); __builtin_amdgcn_s_barrier(); asm volatile("" ::: "memory");
    }
    __device__ __forceinline__ void publish(const f32x4 (&v)[2][2][4][2], const Unit& u, int wr, int wc, int fr, int fq, int wid, int lane) const {
        LAS float* P = (LAS float*)xl;
        float q8[8];
#pragma unroll
        for (int ai = 0; ai < 2; ++ai)
#pragma unroll
            for (int m = 0; m < 4; ++m) {
                float q = 0.f;
#pragma unroll
                for (int bj = 0; bj < 2; ++bj)
#pragma unroll
                    for (int n = 0; n < 2; ++n) { const f32x4 x = v[ai][bj][m][n]; q += (x[0] * x[0] + x[1] * x[1]) + (x[2] * x[2] + x[3] * x[3]); }
                q8[ai * 4 + m] = q;
            }
        { float t8[8];
#pragma unroll
          for (int r = 0; r < 8; ++r) t8[r] = __shfl_xor(q8[r], 16);
#pragma unroll
          for (int r = 0; r < 8; ++r) q8[r] += t8[r];
#pragma unroll
          for (int r = 0; r < 8; ++r) t8[r] = __shfl_xor(q8[r], 32);
#pragma unroll
          for (int r = 0; r < 8; ++r) q8[r] += t8[r]; }
        if (fq == 0) {
#pragma unroll
            for (int r = 0; r < 8; ++r) P[((r >> 2) * HALF + wr * 64 + (r & 3) * 16 + fr) * 4 + wc] = q8[r];
        }
        asm volatile("s_waitcnt lgkmcnt(0)" ::: "memory"); __builtin_amdgcn_s_barrier(); asm volatile("" ::: "memory");
        const int row = wid * 32 + (lane & 31);
        if (lane < 32) ((GAS float*)rs)[((size_t)u.pm * BM + row) * 8 + u.pn] = (P[row * 4 + 0] + P[row * 4 + 1]) + (P[row * 4 + 2] + P[row * 4 + 3]);
    }
    __device__ __forceinline__ void operator()(f32x4 (&acc)[2][2][4][2], const Unit& u, int wr, int wc, int fr_in, int fq_in) const {
        int fr = fr_in, fq = fq_in; asm volatile("" : "+v"(fr), "+v"(fq));
        const int wid = wr * 4 + wc, lane = fq * 16 + fr;
        const LAS float* S = (const LAS float*)(xl + 4096);
        const int col0 = u.pn * BM + wc * 32 + 8 * fq;
        exchange_post(acc, u, wr, wc, fr, fq, wid, lane, 0);
        u32x4 xv[2][4][2];
#pragma unroll
        for (int ai = 0; ai < 2; ++ai)
#pragma unroll
            for (int m = 0; m < 3; ++m)
#pragma unroll
                for (int bj = 0; bj < 2; ++bj)
                    xv[ai][m][bj] = *(const GAS u32x4*)((const GAS bf16_t*)XB + ((size_t)u.pm * BM + ai * HALF + wr * 64 + m * 16 + fr) * DM + col0 + bj * HALF);
        exchange_wait(u, wid, lane, 0, wgt);
#pragma unroll
        for (int ai = 0; ai < 2; ++ai)
#pragma unroll
            for (int bj = 0; bj < 2; ++bj)
                xv[ai][3][bj] = *(const GAS u32x4*)((const GAS bf16_t*)XB + ((size_t)u.pm * BM + ai * HALF + wr * 64 + 3 * 16 + fr) * DM + col0 + bj * HALF);
        f32x4 gp[2][2];
#pragma unroll
        for (int bj = 0; bj < 2; ++bj)
#pragma unroll
            for (int n = 0; n < 2; ++n) gp[bj][n] = *(const GAS f32x4*)((const GAS float*)g_post + col0 + bj * HALF + 4 * n);
#pragma unroll
        for (int ai = 0; ai < 2; ++ai)
#pragma unroll
            for (int m = 0; m < 4; ++m) {
                const int r = ai * HALF + wr * 64 + m * 16 + fr; const float sr = S[r];
                const size_t off = ((size_t)u.pm * BM + r) * DM + col0;
#pragma unroll
                for (int bj = 0; bj < 2; ++bj) {
                    const u32x4 xw = xv[ai][m][bj];
                    const f32x4 x0 = (f32x4){bflo(xw.x), bfhi(xw.x), bflo(xw.y), bfhi(xw.y)}, x1 = (f32x4){bflo(xw.z), bfhi(xw.z), bflo(xw.w), bfhi(xw.w)};
                    const f32x4 o0 = x0 + acc[ai][bj][m][0] * gp[bj][0] * sr, o1 = x1 + acc[ai][bj][m][1] * gp[bj][1] * sr;
                    acc[ai][bj][m][0] = o0; acc[ai][bj][m][1] = o1;
                    if (OUT) { *(GAS f32x4*)((GAS float*)OUT + off + bj * HALF) = o0; *(GAS f32x4*)((GAS float*)OUT + off + bj * HALF + 4) = o1; }
                    else { u32x4 w; w.x = cvt_pk_bf16(o0[0], o0[1]); w.y = cvt_pk_bf16(o0[2], o0[3]); w.z = cvt_pk_bf16(o1[0], o1[1]); w.w = cvt_pk_bf16(o1[2], o1[3]);
                           *(GAS u32x4*)((GAS bf16_t*)XB + off + bj * HALF) = w; }
                }
            }
        if (!OUT) publish(acc, u, wr, wc, fr, fq, wid, lane);
    }
};

template <class Epi, class Sched, bool HALFN = false>
__device__ __forceinline__ void gemm_phase(LAS unsigned char* lds, const Gemm g, const Sched& S, const Epi& E) {
    const int tid = fresh_tid(), wid = __builtin_amdgcn_readfirstlane(tid >> 6), lane = tid & 63, wr = wid >> 2, wc = wid & 3, fr = lane & 15, fq = lane >> 4;
    const int nt = g.K / BK;
    unsigned voffA[2], voffB[2];
#pragma unroll
    for (int i = 0; i < 2; ++i) { int R, C; stage_rc(tid * 16 + i * 8192, R, C); const int Rb = (R & ~31) + perm32(R & 31);
        voffA[i] = (unsigned)(R * g.lda + C) * 2u; voffB[i] = (unsigned)(Rb * g.ldb + C) * 2u; }
    const size_t kstep = (size_t)(BK * 2);
    const size_t hA = (size_t)HALF * g.lda * 2, hB = (size_t)HALF * g.ldb * 2, tA = 2 * hA, tB = HALFN ? hB : 2 * hB;
    const unsigned ldsw = (unsigned)wid * 1024u;
    const int aoff = lds_byte(wr * 64 + fr, fq * 8), boff = lds_byte(wc * 32 + fr, fq * 8);
#define PG8_SA(b, h) (((b) * 2 + (h)) * HTB)
#define PG8_SB(b, h) ((4 + (b) * 2 + (h)) * HTB)
#define PG8_STAGE(bufoff, gbase, voff) do { _Pragma("unroll") for (int _i = 0; _i < 2; ++_i) \
        __builtin_amdgcn_global_load_lds((const GAS unsigned*)((const GAS char*)(gbase) + (voff)[_i]), (LAS unsigned*)(lds + (bufoff) + ldsw + _i * 8192), 16, 0, 0); } while (0)
#define PG8_LDA(dst, b, h) do { _Pragma("unroll") for (int m = 0; m < 4; ++m) _Pragma("unroll") for (int k = 0; k < 2; ++k) dst[m][k] = *(const LAS bf16x8*)(lds + PG8_SA(b, h) + aoff + m * 2048 + k * 1024); } while (0)
#define PG8_LDB(dst, b, h) do { _Pragma("unroll") for (int n = 0; n < 2; ++n) _Pragma("unroll") for (int k = 0; k < 2; ++k) dst[n][k] = *(const LAS bf16x8*)(lds + PG8_SB(b, h) + boff + n * 2048 + k * 1024); } while (0)
#define PG8_MMA(ai, bj, At, Bt) do { __builtin_amdgcn_s_setprio(1); _Pragma("unroll") for (int m = 0; m < 4; ++m) _Pragma("unroll") for (int n = 0; n < 2; ++n) _Pragma("unroll") for (int k = 0; k < 2; ++k) \
        acc[ai][bj][m][n] = __builtin_amdgcn_mfma_f32_16x16x32_bf16(Bt[n][k], At[m][k], acc[ai][bj][m][n], 0, 0, 0); __builtin_amdgcn_s_setprio(0); } while (0)
#define PG8_WAIT_V(n) asm volatile("s_waitcnt vmcnt(" #n ")" ::: "memory")
#define PG8_WAIT_L(n) asm volatile("s_waitcnt lgkmcnt(" #n ")" ::: "memory")
#define PG8_BAR __builtin_amdgcn_s_barrier()
#define PG8_SCHED __builtin_amdgcn_sched_barrier(0)
    Unit cur, nxt; int ui = 0;
    if (!S.next(0, cur)) return;
    cur.ord = 0;
    f32x4 acc[2][2][4][2];
#pragma unroll
    for (int a = 0; a < 2; ++a)
#pragma unroll
        for (int b = 0; b < 2; ++b)
#pragma unroll
            for (int m = 0; m < 4; ++m)
#pragma unroll
                for (int n = 0; n < 2; ++n) acc[a][b][m][n] = (f32x4){0.f, 0.f, 0.f, 0.f};
    bf16x8 At[4][2], B0[2][2], B1[2][2];
    const GAS char* cA = (const GAS char*)g.A + (size_t)cur.pm * tA + (size_t)(cur.pn >> g.a_shift) * g.a_stride;
    const GAS char* cB = (const GAS char*)g.Bt + (size_t)cur.pn * tB;
    PG8_STAGE(PG8_SB(0, 0), cB, voffB); PG8_STAGE(PG8_SB(0, 1), cB + hB, voffB); PG8_STAGE(PG8_SA(0, 0), cA, voffA); PG8_STAGE(PG8_SA(0, 1), cA + hA, voffA);
    if (wr == 1) PG8_BAR;
    PG8_WAIT_V(2); PG8_BAR;
    PG8_STAGE(PG8_SB(1, 0), cB + kstep, voffB); PG8_STAGE(PG8_SA(1, 0), cA + kstep, voffA); PG8_STAGE(PG8_SB(1, 1), cB + hB + kstep, voffB);
    PG8_WAIT_V(6); PG8_BAR;
    for (;;) {
        const bool has_next = S.next(ui + 1, nxt); nxt.ord = ui + 1;
        const GAS char* nA = has_next ? (const GAS char*)g.A + (size_t)nxt.pm * tA + (size_t)(nxt.pn >> g.a_shift) * g.a_stride : cA;
        const GAS char* nB = has_next ? (const GAS char*)g.Bt + (size_t)nxt.pn * tB : cB;
        for (int t = 0; t < nt; t += 2) {
            const bool last = (t == nt - 2);
            const GAS char* a1 = cA + (size_t)(t + 1) * kstep;
            const GAS char* a2 = last ? nA : cA + (size_t)(t + 2) * kstep; const GAS char* b2 = last ? nB : cB + (size_t)(t + 2) * kstep;
            const GAS char* a3 = a2 + kstep; const GAS char* b3 = b2 + kstep;
            PG8_LDB(B0, 0, 0); if constexpr (!HALFN) PG8_LDB(B1, 0, 1); PG8_SCHED; PG8_LDA(At, 0, 0); PG8_STAGE(PG8_SA(1, 1), a1 + hA, voffA);
            PG8_WAIT_V(8); PG8_WAIT_L(0); PG8_BAR; PG8_MMA(0, 0, At, B0); if constexpr (!HALFN) PG8_MMA(0, 1, At, B1); PG8_BAR; PG8_SCHED;
            PG8_LDA(At, 0, 1); PG8_STAGE(PG8_SB(0, 0), b2, voffB); PG8_STAGE(PG8_SB(0, 1), b2 + hB, voffB); PG8_STAGE(PG8_SA(0, 0), a2, voffA);
            PG8_WAIT_V(8); PG8_WAIT_L(0); PG8_BAR; PG8_MMA(1, 0, At, B0); if constexpr (!HALFN) PG8_MMA(1, 1, At, B1); PG8_BAR; PG8_SCHED;
            PG8_LDB(B0, 1, 0); if constexpr (!HALFN) PG8_LDB(B1, 1, 1); PG8_SCHED; PG8_LDA(At, 1, 0); PG8_STAGE(PG8_SA(0, 1), a2 + hA, voffA);
            PG8_WAIT_V(8); PG8_WAIT_L(0); PG8_BAR; PG8_MMA(0, 0, At, B0); if constexpr (!HALFN) PG8_MMA(0, 1, At, B1); PG8_BAR; PG8_SCHED;
            PG8_LDA(At, 1, 1); PG8_STAGE(PG8_SB(1, 0), b3, voffB); PG8_STAGE(PG8_SB(1, 1), b3 + hB, voffB); PG8_STAGE(PG8_SA(1, 0), a3, voffA);
            PG8_WAIT_V(8); PG8_WAIT_L(0); PG8_BAR; PG8_MMA(1, 0, At, B0); if constexpr (!HALFN) PG8_MMA(1, 1, At, B1); PG8_BAR; PG8_SCHED;
        }
        if (wr == 0) PG8_BAR;
        E(acc, cur, wr, wc, fr, fq);
        if (!has_next) break;
#pragma unroll
        for (int a = 0; a < 2; ++a)
#pragma unroll
            for (int b = 0; b < 2; ++b)
#pragma unroll
                for (int m = 0; m < 4; ++m)
#pragma unroll
                    for (int n = 0; n < 2; ++n) acc[a][b][m][n] = (f32x4){0.f, 0.f, 0.f, 0.f};
        cur = nxt; cA = nA; cB = nB; ++ui;
        if (wr == 1) PG8_BAR;
    }
    PG8_WAIT_V(0);
    PG8_BAR;
#undef PG8_SA
#undef PG8_SB
#undef PG8_STAGE
#undef PG8_LDA
#undef PG8_LDB
#undef PG8_MMA
#undef PG8_WAIT_V
#undef PG8_WAIT_L
#undef PG8_BAR
#undef PG8_SCHED
}
}

__device__ __forceinline__ void norm_pass(const float* xin, float* xout, const float* y, const float* part, float wgt, const float* g_post, const float* g_pre, bf16_t* h,
                                          int nrows, int gw, int ngw, int lane) {
    for (int row = gw; row < nrows; row += ngw) {
        const GAS f32x4* xr = (const GAS f32x4*)(xin + (size_t)row * DM) + lane;
        f32x4 v[8];
#pragma unroll
        for (int j = 0; j < 8; ++j) v[j] = xr[64 * j];
        if (y) {
            const float ps = (lane < 32) ? ((const GAS float*)part)[(size_t)lane * MTOK + row] : 0.f;
            const float ss = wave_sum(ps);
            const float r = wgt * rsqrtf(ss * (1.0f / DM) + EPS);
            const GAS f32x4* yr = (const GAS f32x4*)(y + (size_t)row * DM) + lane; const GAS f32x4* gp = (const GAS f32x4*)g_post + lane;
#pragma unroll
            for (int j = 0; j < 8; ++j) v[j] += yr[64 * j] * gp[64 * j] * r;
        }
        if (xout) { GAS f32x4* xo = (GAS f32x4*)(xout + (size_t)row * DM) + lane;
#pragma unroll
            for (int j = 0; j < 8; ++j) xo[64 * j] = v[j]; }
        if (h) {
            float s2 = 0.f;
#pragma unroll
            for (int j = 0; j < 8; ++j) s2 += (v[j][0] * v[j][0] + v[j][1] * v[j][1]) + (v[j][2] * v[j][2] + v[j][3] * v[j][3]);
            s2 = wave_sum(s2);
            const float r2 = rsqrtf(s2 * (1.0f / DM) + EPS);
            const GAS f32x4* gq = (const GAS f32x4*)g_pre + lane; GAS u32x2* ho = (GAS u32x2*)(h + (size_t)row * DM) + lane;
#pragma unroll
            for (int j = 0; j < 8; ++j) { const f32x4 o = v[j] * gq[64 * j] * r2; u32x2 w; w.x = cvt_pk_bf16(o[0], o[1]); w.y = cvt_pk_bf16(o[2], o[3]); ho[64 * j] = w; }
        }
    }
}

__device__ __forceinline__ void prep_pass(const float* xin, bf16_t* xb, float* rs, int nrows, int gw, int ngw, int lane) {
    for (int row = gw; row < nrows; row += ngw) {
        const GAS f32x4* xr = (const GAS f32x4*)(xin + (size_t)row * DM) + lane;
        f32x4 v[8];
#pragma unroll
        for (int j = 0; j < 8; ++j) v[j] = xr[64 * j];
        float s2 = 0.f;
#pragma unroll
        for (int j = 0; j < 8; ++j) s2 += (v[j][0] * v[j][0] + v[j][1] * v[j][1]) + (v[j][2] * v[j][2] + v[j][3] * v[j][3]);
        s2 = wave_sum(s2);
        GAS u32x2* ho = (GAS u32x2*)(xb + (size_t)row * DM) + lane;
#pragma unroll
        for (int j = 0; j < 8; ++j) { u32x2 w; w.x = cvt_pk_bf16(v[j][0], v[j][1]); w.y = cvt_pk_bf16(v[j][2], v[j][3]); ho[64 * j] = w; }
        if (lane < 8) ((GAS float*)rs)[(size_t)row * 8 + lane] = (lane == 0) ? s2 : 0.f;
    }
}

__device__ __forceinline__ void rope_rot(const u32x4 x1, const u32x4 x2, const f32x2* tb, u32x4& r1, u32x4& r2) {
    const GAS f32x4* t = (const GAS f32x4*)tb;
#pragma unroll
    for (int p = 0; p < 4; ++p) {
        const f32x4 cc = t[p]; const f32x2 c0 = {cc[0], cc[1]}, c1 = {cc[2], cc[3]};
        const float a0 = bflo(x1[p]), a1 = bfhi(x1[p]), b0 = bflo(x2[p]), b1 = bfhi(x2[p]);
        r1[p] = cvt_pk_bf16(a0 * c0.x - b0 * c0.y, a1 * c1.x - b1 * c1.y);
        r2[p] = cvt_pk_bf16(b0 * c0.x + a0 * c0.y, b1 * c1.x + a1 * c1.y);
    }
}

__device__ __forceinline__ void rope_rot_t(const u32x4 x1, const u32x4 x2, const f32x4 (&cc)[4], u32x4& r1, u32x4& r2) {
#pragma unroll
    for (int p = 0; p < 4; ++p) {
        const f32x2 c0 = {cc[p][0], cc[p][1]}, c1 = {cc[p][2], cc[p][3]};
        const float a0 = bflo(x1[p]), a1 = bfhi(x1[p]), b0 = bflo(x2[p]), b1 = bfhi(x2[p]);
        r1[p] = cvt_pk_bf16(a0 * c0.x - b0 * c0.y, a1 * c1.x - b1 * c1.y);
        r2[p] = cvt_pk_bf16(b0 * c0.x + a0 * c0.y, b1 * c1.x + a1 * c1.y);
    }
}
constexpr int SA_KLD = 72, SA_VLD = 280;
__device__ __forceinline__ void attn_unit(LAS unsigned char* lds, const bf16_t* z, bf16_t* cat, const f32x2* rope, const float* sinks, int unit, int tid, int wid, int lane) {
    const int kvh = unit & 1, blk = (unit >> 1) & 31, b = unit >> 6;
    const int tokq = b * SEQ + blk * 128, tokk = tokq - 128;
    LAS bf16_t* Ks = (LAS bf16_t*)lds;
    LAS bf16_t* Vt = (LAS bf16_t*)(lds + 256 * SA_KLD * 2);
    const GAS bf16_t* zg = (const GAS bf16_t*)z;
    {
        u32x4 kva[4], vva[4], x1a[4], x2a[4]; f32x4 tba[4][4];
#pragma unroll
        for (int c = 0; c < 4; ++c) {
            const int idx = tid + 512 * c, key = idx >> 3, ch = idx & 7;
            const int pos = blk * 128 - 128 + key; const bool okp = pos >= 0;
            const GAS bf16_t* zr = zg + (size_t)(okp ? tokk + key : tokq) * INW;
            kva[c] = *(const GAS u32x4*)(zr + 1024 + kvh * 64 + ch * 8);
            vva[c] = *(const GAS u32x4*)(zr + 1152 + kvh * 64 + ch * 8);
            x1a[c] = *(const GAS u32x4*)(zr + 1024 + kvh * 64); x2a[c] = *(const GAS u32x4*)(zr + 1024 + kvh * 64 + 8);
            const GAS f32x4* tp = (const GAS f32x4*)(rope + (size_t)(okp ? pos : 0) * 8);
#pragma unroll
            for (int p = 0; p < 4; ++p) tba[c][p] = tp[p];
        }
        asm volatile("" ::: "memory");
#pragma unroll
        for (int c = 0; c < 4; ++c) {
            const int idx = tid + 512 * c, key = idx >> 3, ch = idx & 7;
            const bool okp = (blk * 128 - 128 + key) >= 0;
            u32x4 r1, r2; rope_rot_t(x1a[c], x2a[c], tba[c], r1, r2);
            u32x4 kv = ch == 0 ? r1 : (ch == 1 ? r2 : kva[c]), vv = vva[c];
            if (!okp) { kv = (u32x4){0u, 0u, 0u, 0u}; vv = (u32x4){0u, 0u, 0u, 0u}; }
            *(LAS u32x4*)(Ks + key * SA_KLD + ch * 8) = kv;
#pragma unroll
            for (int p = 0; p < 4; ++p) { Vt[(ch * 8 + 2 * p) * SA_VLD + key] = (bf16_t)(vv[p] & 0xffffu); Vt[(ch * 8 + 2 * p + 1) * SA_VLD + key] = (bf16_t)(vv[p] >> 16); }
        }
    }
    for (int idx = tid; idx < 64 * 24; idx += 512) Vt[(idx / 24) * SA_VLD + 256 + (idx % 24)] = 0;
    __syncthreads();
    const int hq = kvh * 8 + wid; const float sink = ((const GAS float*)sinks)[hq];
    const int qi = lane & 15, g = lane >> 4;
    for (int qs = 0; qs < 8; ++qs) {
        const int row = tokq + 16 * qs + qi, pos = blk * 128 + 16 * qs + qi;
        const GAS bf16_t* zr = zg + (size_t)row * INW + hq * 64;
        bf16x8 qf0, qf1;
        { const u32x4 x1 = *(const GAS u32x4*)(zr), x2 = *(const GAS u32x4*)(zr + 8); u32x4 r1, r2; rope_rot(x1, x2, rope + (size_t)pos * 8, r1, r2);
          const u32x4 own = *(const GAS u32x4*)(zr + 8 * g);
          const u32x4 sel = g == 0 ? r1 : (g == 1 ? r2 : own); qf0 = __builtin_bit_cast(bf16x8, sel); }
        qf1 = __builtin_bit_cast(bf16x8, *(const GAS u32x4*)(zr + 32 + 8 * g));
        f32x4 s[9];
#pragma unroll
        for (int t = 0; t < 9; ++t) {
            const LAS bf16_t* kp = Ks + (16 * (qs + t) + qi) * SA_KLD + 8 * g;
            const bf16x8 a0 = *(const LAS bf16x8*)kp, a1 = *(const LAS bf16x8*)(kp + 32);
            f32x4 acc = (f32x4){0.f, 0.f, 0.f, 0.f};
            acc = MFMA16(a0, qf0, acc); acc = MFMA16(a1, qf1, acc); s[t] = acc;
            if ((t % 3) == 2) __builtin_amdgcn_sched_barrier(0);
        }
        float mx = sink;
        const int i = 16 * qs + qi;
#pragma unroll
        for (int t = 0; t < 9; ++t)
#pragma unroll
            for (int r = 0; r < 4; ++r) {
                const int j = 16 * (qs + t) + 4 * g + r;
                const bool valid = (j > i) && (j <= i + 128) && (blk > 0 || j >= 128);
                const float v = valid ? s[t][r] * 0.125f : -1e30f; s[t][r] = v; mx = fmaxf(mx, v);
            }
        mx = fmaxf(mx, __shfl_xor(mx, 16)); mx = fmaxf(mx, __shfl_xor(mx, 32));
        float l = 0.f;
#pragma unroll
        for (int t = 0; t < 9; ++t)
#pragma unroll
            for (int r = 0; r < 4; ++r) { const float e = __expf(s[t][r] - mx); s[t][r] = e; l += e; }
        l += __shfl_xor(l, 16); l += __shfl_xor(l, 32); l += __expf(sink - mx);
        const float inv = 1.0f / l;
        bf16x8 pf[5];
#pragma unroll
        for (int s5 = 0; s5 < 5; ++s5) {
            u32x4 w; w.x = cvt_pk_bf16(s[2 * s5][0], s[2 * s5][1]); w.y = cvt_pk_bf16(s[2 * s5][2], s[2 * s5][3]);
            if (2 * s5 + 1 < 9) { w.z = cvt_pk_bf16(s[(2 * s5 + 1) % 9][0], s[(2 * s5 + 1) % 9][1]); w.w = cvt_pk_bf16(s[(2 * s5 + 1) % 9][2], s[(2 * s5 + 1) % 9][3]); } else { w.z = 0u; w.w = 0u; }
            pf[s5] = __builtin_bit_cast(bf16x8, w);
        }
#pragma unroll
        for (int dt = 0; dt < 4; ++dt) {
            f32x4 acc = (f32x4){0.f, 0.f, 0.f, 0.f};
#pragma unroll
            for (int s5 = 0; s5 < 5; ++s5) {
                const LAS bf16_t* vp = Vt + (16 * dt + qi) * SA_VLD + 16 * (qs + 2 * s5) + 4 * g;
                const s16x4 lo = *(const LAS s16x4*)vp, hi = *(const LAS s16x4*)(vp + 16);
                const bf16x8 a = __builtin_shufflevector(lo, hi, 0, 1, 2, 3, 4, 5, 6, 7);
                acc = MFMA16(a, pf[s5], acc);
            }
            u32x2 w; w.x = cvt_pk_bf16(acc[0] * inv, acc[1] * inv); w.y = cvt_pk_bf16(acc[2] * inv, acc[3] * inv);
            *(GAS u32x2*)((GAS bf16_t*)cat + (size_t)row * DM + hq * 64 + 16 * dt + 4 * g) = w;
            __builtin_amdgcn_sched_barrier(0);
        }
    }
    __syncthreads();
}

constexpr int SG_LD = 136;
__device__ __forceinline__ void sgu_unit(LAS unsigned char* lds, const bf16_t* z, bf16_t* cat, const f32x2* sst, const bf16_t* wsgu, const float* ln_g, const float* ln_b, const float* b_s,
                                         int unit, int tid, int wid, int lane) {
    const int grp = unit & 7, chunk = (unit >> 3) & 31, b = unit >> 8;
    const int tb = b * SEQ + chunk * 128;
    LAS bf16_t* Vt = (LAS bf16_t*)lds;
    LAS bf16_t* Wl = (LAS bf16_t*)(lds + 128 * SG_LD * 2);
    LAS float* mu = (LAS float*)(lds + 2 * 128 * SG_LD * 2); LAS float* rs = mu + 128;
    const GAS bf16_t* zg = (const GAS bf16_t*)z;
    if (tid < 128) {
        float s1 = 0.f, s2 = 0.f;
#pragma unroll
        for (int p = 0; p < 16; ++p) { const f32x2 v = ((const GAS f32x2*)sst)[(size_t)p * MTOK + tb + tid]; s1 += v.x; s2 += v.y; }
        const float m = s1 * (1.0f / 1024.0f); const float var = fmaxf(s2 * (1.0f / 1024.0f) - m * m, 0.f);
        mu[tid] = m; rs[tid] = rsqrtf(var + EPS);
    }
    __syncthreads();
    {
        const int ch = tid & 15;
        u32x4 vva[4], wwa[4];
#pragma unroll
        for (int c = 0; c < 4; ++c) {
            const int idx = tid + 512 * c, j = idx >> 4;
            vva[c] = *(const GAS u32x4*)(zg + (size_t)(tb + j) * INW + 2304 + grp * 128 + ch * 8);
            wwa[c] = *(const GAS u32x4*)((const GAS bf16_t*)wsgu + (size_t)grp * 16384 + j * 128 + ch * 8);
        }
        const GAS float* lg = (const GAS float*)ln_g + grp * 128 + ch * 8; const GAS float* lb = (const GAS float*)ln_b + grp * 128 + ch * 8;
        const f32x4 lg0 = *(const GAS f32x4*)lg, lg1 = *(const GAS f32x4*)(lg + 4), lb0 = *(const GAS f32x4*)lb, lb1 = *(const GAS f32x4*)(lb + 4);
        const float lgv[8] = {lg0[0], lg0[1], lg0[2], lg0[3], lg1[0], lg1[1], lg1[2], lg1[3]}, lbv[8] = {lb0[0], lb0[1], lb0[2], lb0[3], lb1[0], lb1[1], lb1[2], lb1[3]};
        asm volatile("" ::: "memory");
#pragma unroll
        for (int c = 0; c < 4; ++c) {
            const int idx = tid + 512 * c, j = idx >> 4;
            const float m = mu[j], r = rs[j];
#pragma unroll
            for (int p = 0; p < 4; ++p) {
                const float v0 = (bflo(vva[c][p]) - m) * r * lgv[2 * p] + lbv[2 * p], v1 = (bfhi(vva[c][p]) - m) * r * lgv[2 * p + 1] + lbv[2 * p + 1];
                const unsigned w = cvt_pk_bf16(v0, v1);
                Vt[(ch * 8 + 2 * p) * SG_LD + j] = (bf16_t)(w & 0xffffu); Vt[(ch * 8 + 2 * p + 1) * SG_LD + j] = (bf16_t)(w >> 16);
            }
            *(LAS u32x4*)(Wl + j * SG_LD + ch * 8) = wwa[c];
        }
    }
    __syncthreads();
    const int li = lane & 15, g = lane >> 4;
    u32x2 uuv[8]; float biasv[8];
#pragma unroll
    for (int it = 0; it < 8; ++it) {
        uuv[it] = *(const GAS u32x2*)(zg + (size_t)(tb + 16 * it + li) * INW + 1280 + grp * 128 + 16 * wid + 4 * g);
        biasv[it] = ((const GAS float*)b_s)[grp * 128 + 16 * it + li];
    }
#pragma unroll
    for (int it = 0; it < 8; ++it) {
        f32x4 acc = (f32x4){0.f, 0.f, 0.f, 0.f};
#pragma unroll
        for (int ks = 0; ks < 4; ++ks) {
            if (32 * ks <= 16 * it + 15) {
                const bf16x8 a = *(const LAS bf16x8*)(Vt + (16 * wid + li) * SG_LD + 32 * ks + 8 * g);
                const bf16x8 bb = *(const LAS bf16x8*)(Wl + (16 * it + li) * SG_LD + 32 * ks + 8 * g);
                acc = MFMA16(a, bb, acc);
            }
        }
        const int tok = tb + 16 * it + li; const int c0 = grp * 128 + 16 * wid + 4 * g;
        const float bias = biasv[it];
        const u32x2 uu = uuv[it];
        u32x2 w; w.x = cvt_pk_bf16(bflo(uu.x) * (acc[0] + bias), bfhi(uu.x) * (acc[1] + bias)); w.y = cvt_pk_bf16(bflo(uu.y) * (acc[2] + bias), bfhi(uu.y) * (acc[3] + bias));
        *(GAS u32x2*)((GAS bf16_t*)cat + (size_t)tok * DM + 1024 + c0) = w;
    }
    __syncthreads();
}

constexpr int XA_KLD = 136, XA_VLD = 264;
__device__ __forceinline__ void xattn_unit(LAS unsigned char* lds, const bf16_t* q, const bf16_t* kv, bf16_t* o, int unit, int tid, int wid, int lane) {
    const int qb = unit & 15, head = (unit >> 4) & 3, b = unit >> 6;
    LAS bf16_t* Kc = (LAS bf16_t*)lds;
    LAS bf16_t* Vt = (LAS bf16_t*)(lds + 256 * XA_KLD * 2);
    const GAS bf16_t* kvg = (const GAS bf16_t*)kv;
    {
        u32x4 kka[8], vva[8];
#pragma unroll
        for (int c = 0; c < 8; ++c) {
            const int idx = tid + 512 * c, key = idx >> 4, ch = idx & 15;
            const GAS bf16_t* kr = kvg + (size_t)(b * 256 + key) * 1024 + head * 128 + ch * 8;
            kka[c] = *(const GAS u32x4*)kr; vva[c] = *(const GAS u32x4*)(kr + 512);
        }
        asm volatile("" ::: "memory");
#pragma unroll
        for (int c = 0; c < 8; ++c) {
            const int idx = tid + 512 * c, key = idx >> 4, ch = idx & 15;
            *(LAS u32x4*)(Kc + key * XA_KLD + ch * 8) = kka[c];
#pragma unroll
            for (int p = 0; p < 4; ++p) { Vt[(ch * 8 + 2 * p) * XA_VLD + key] = (bf16_t)(vva[c][p] & 0xffffu); Vt[(ch * 8 + 2 * p + 1) * XA_VLD + key] = (bf16_t)(vva[c][p] >> 16); }
        }
    }
    __syncthreads();
    const int qi = lane & 15, g = lane >> 4;
    for (int sb = 0; sb < 2; ++sb) {
        const int row = b * SEQ + qb * 256 + wid * 32 + sb * 16 + qi;
        const GAS bf16_t* qr = (const GAS bf16_t*)q + (size_t)row * 512 + head * 128 + 8 * g;
        bf16x8 qf[4];
#pragma unroll
        for (int ks = 0; ks < 4; ++ks) qf[ks] = __builtin_bit_cast(bf16x8, *(const GAS u32x4*)(qr + 32 * ks));
        f32x4 s[16];
#pragma unroll
        for (int kt = 0; kt < 16; ++kt) {
            f32x4 acc = (f32x4){0.f, 0.f, 0.f, 0.f};
#pragma unroll
            for (int ks = 0; ks < 4; ++ks) { const bf16x8 a = *(const LAS bf16x8*)(Kc + (16 * kt + qi) * XA_KLD + 32 * ks + 8 * g); acc = MFMA16(a, qf[ks], acc); }
            s[kt] = acc * 0.08838834764831845f;
            if (kt & 1) __builtin_amdgcn_sched_barrier(0);
        }
        float mx = -1e30f;
#pragma unroll
        for (int kt = 0; kt < 16; ++kt) mx = fmaxf(fmaxf(mx, fmaxf(s[kt][0], s[kt][1])), fmaxf(s[kt][2], s[kt][3]));
        mx = fmaxf(mx, __shfl_xor(mx, 16)); mx = fmaxf(mx, __shfl_xor(mx, 32));
        float l = 0.f;
#pragma unroll
        for (int kt = 0; kt < 16; ++kt)
#pragma unroll
            for (int r = 0; r < 4; ++r) { const float e = __expf(s[kt][r] - mx); s[kt][r] = e; l += e; }
        l += __shfl_xor(l, 16); l += __shfl_xor(l, 32);
        const float inv = 1.0f / l;
        bf16x8 pf[8];
#pragma unroll
        for (int s8 = 0; s8 < 8; ++s8) {
            u32x4 w; w.x = cvt_pk_bf16(s[2 * s8][0], s[2 * s8][1]); w.y = cvt_pk_bf16(s[2 * s8][2], s[2 * s8][3]);
            w.z = cvt_pk_bf16(s[2 * s8 + 1][0], s[2 * s8 + 1][1]); w.w = cvt_pk_bf16(s[2 * s8 + 1][2], s[2 * s8 + 1][3]);
            pf[s8] = __builtin_bit_cast(bf16x8, w);
        }
#pragma unroll
        for (int dt = 0; dt < 8; ++dt) {
            f32x4 acc = (f32x4){0.f, 0.f, 0.f, 0.f};
#pragma unroll
            for (int s8 = 0; s8 < 8; ++s8) {
                const LAS bf16_t* vp = Vt + (16 * dt + qi) * XA_VLD + 32 * s8 + 4 * g;
                const s16x4 lo = *(const LAS s16x4*)vp, hi = *(const LAS s16x4*)(vp + 16);
                const bf16x8 a = __builtin_shufflevector(lo, hi, 0, 1, 2, 3, 4, 5, 6, 7);
                acc = MFMA16(a, pf[s8], acc);
            }
            u32x2 w; w.x = cvt_pk_bf16(acc[0] * inv, acc[1] * inv); w.y = cvt_pk_bf16(acc[2] * inv, acc[3] * inv);
            *(GAS u32x2*)((GAS bf16_t*)o + (size_t)row * 512 + head * 128 + 16 * dt + 4 * g) = w;
            __builtin_amdgcn_sched_barrier(0);
        }
    }
    __syncthreads();
}

template <int W>
__device__ __forceinline__ void pool_body(const LAS float* R, const GAS bf16_t* hg, const f32x4 gv, GAS bf16_t* pg, int t0, int s0) {
    constexpr int NR = W - 1 + 32;
    u32x2 v[NR];
#pragma unroll
    for (int k = 0; k < NR; ++k) { const int tok = t0 - (W - 1) + k; v[k] = *(const GAS u32x2*)(hg + (size_t)(tok < 0 ? 0 : tok) * DM); }
    f32x4 sum = (f32x4){0.f, 0.f, 0.f, 0.f};
#pragma unroll
    for (int k = 0; k < W - 1; ++k) { const float r = R[16 - W + k]; sum += (f32x4){bflo(v[k].x), bfhi(v[k].x), bflo(v[k].y), bfhi(v[k].y)} * r; }
#pragma unroll
    for (int i = 0; i < 32; ++i) {
        const float r = R[15 + i];
        const f32x4 cur = (f32x4){bflo(v[W - 1 + i].x), bfhi(v[W - 1 + i].x), bflo(v[W - 1 + i].y), bfhi(v[W - 1 + i].y)} * r;
        const int cnt = (s0 + i + 1) < W ? (s0 + i + 1) : W;
        const float ic = 1.0f / (float)cnt;
        sum += cur;
        const f32x4 o = (sum * ic - cur) * gv;
        u32x2 wv; wv.x = cvt_pk_bf16(o[0], o[1]); wv.y = cvt_pk_bf16(o[2], o[3]);
        *(GAS u32x2*)(pg + (size_t)(t0 + i) * DM) = wv;
        const float ro = R[15 + i - (W - 1)];
        sum -= (f32x4){bflo(v[i].x), bfhi(v[i].x), bflo(v[i].y), bfhi(v[i].y)} * ro;
    }
}
__device__ __forceinline__ void pool_unit(LAS unsigned char* lds, const bf16_t* xb, const float* rs, const float* gpre, bf16_t* pooled, int unit, int tid) {
    LAS float* R = (LAS float*)lds;
    const int t0 = unit * 32, s0 = t0 & (SEQ - 1);
    if (tid < 47) { const int tok = t0 - 15 + tid; R[tid] = ((s0 - 15 + tid) >= 0) ? row_rs(rs, tok) : 0.f; }
    __syncthreads();
    const int c0 = tid * 4;
    const GAS bf16_t* hg = (const GAS bf16_t*)xb + c0; GAS bf16_t* pg = (GAS bf16_t*)pooled + c0;
    const f32x4 gv = *(const GAS f32x4*)((const GAS float*)gpre + c0);
    const int grp = __builtin_amdgcn_readfirstlane(c0 >> 9);
    if (grp == 0) pool_body<2>(R, hg, gv, pg, t0, s0);
    else if (grp == 1) pool_body<4>(R, hg, gv, pg, t0, s0);
    else if (grp == 2) pool_body<8>(R, hg, gv, pg, t0, s0);
    else pool_body<16>(R, hg, gv, pg, t0, s0);
    __syncthreads();
}

#define XB_TMO      128
#define XB_XCNT(j)  (256  + 64 * (j))
#define XB_XSUB(j)  (1280 + 64 * (j))
#define XB_XGEN(j)  (2304 + 64 * (j))
#define XB_TOP      3328
#define XB_TOPGEN   3392
#define XCD_BAR_WORDS 3456
#define XB_SPIN_CAP (1u << 22)
__device__ __forceinline__ unsigned xb_ld(unsigned* p)              { return __hip_atomic_load(p, __ATOMIC_RELAXED, __HIP_MEMORY_SCOPE_AGENT); }
__device__ __forceinline__ unsigned xb_add(unsigned* p, unsigned v) { return __hip_atomic_fetch_add(p, v, __ATOMIC_RELAXED, __HIP_MEMORY_SCOPE_AGENT); }
__device__ __forceinline__ unsigned xb_xcc_id() { return (unsigned)__builtin_amdgcn_s_getreg((3 << 11) | 20) & 0xFu; }
#define XB_SPIN(cond, bar) do { unsigned _sp = 0; while (cond) { __builtin_amdgcn_s_sleep(1); \
    if ((++_sp & 255u) == 0u) { if (xb_ld(&(bar)[XB_TMO])) break; if (_sp > XB_SPIN_CAP) { atomicAdd(&(bar)[XB_TMO], 1u); break; } } } } while (0)
struct XcdBarrier { unsigned* bar; unsigned x; volatile LAS unsigned* st; };
__device__ __forceinline__ XcdBarrier xcd_barrier_post(unsigned* bar, volatile LAS unsigned* st) {
    XcdBarrier b; b.bar = bar; b.x = xb_xcc_id(); b.st = st;
    if (threadIdx.x == 0) (void)xb_add(&bar[XB_XCNT(b.x)], 1u);
    return b;
}
__device__ __forceinline__ void xcd_barrier_complete(unsigned* bar, unsigned x, unsigned& nloc, unsigned& nx) {
    const unsigned G = gridDim.x * gridDim.y * gridDim.z;
    unsigned sum, cnt, mine, sp = 0u;
    for (;;) {
        sum = 0u; cnt = 0u; mine = 0u;
#pragma unroll
        for (unsigned j = 0; j < 16; ++j) { const unsigned c = xb_ld(&bar[XB_XCNT(j)]); sum += c; cnt += (c > 0u) ? 1u : 0u; mine = (j == x) ? c : mine; }
        if (sum == G) break;
        __builtin_amdgcn_s_sleep(1);
        if ((++sp & 255u) == 0u) { if (xb_ld(&bar[XB_TMO])) break; if (sp > XB_SPIN_CAP) { atomicAdd(&bar[XB_TMO], 1u); break; } }
    }
    nloc = mine > 0u ? mine : 1u; nx = cnt > 0u ? cnt : 1u;
}
__device__ __forceinline__ void xcd_barrier(const XcdBarrier& b) {
    asm volatile("s_waitcnt vmcnt(0)" ::: "memory");
    __syncthreads();
    if (threadIdx.x == 0) {
        unsigned* bar = b.bar;
        __builtin_amdgcn_s_waitcnt(0);
        unsigned nloc = b.st[0], nx = b.st[1];
        if (nloc == 0u) { xcd_barrier_complete(bar, b.x, nloc, nx); b.st[0] = nloc; b.st[1] = nx; }
        const unsigned old = xb_add(&bar[XB_XSUB(b.x)], 1u);
        const unsigned gen = old / nloc;
        if (old + 1u == (gen + 1u) * nloc) {
            __builtin_amdgcn_fence(__ATOMIC_RELEASE, "agent");
            asm volatile("s_waitcnt vmcnt(0)" ::: "memory");
            const unsigned og = xb_add(&bar[XB_TOP], 1u);
            const unsigned tg = og / nx;
            if (og + 1u == (tg + 1u) * nx) xb_add(&bar[XB_TOPGEN], 1u);
            else XB_SPIN(xb_ld(&bar[XB_TOPGEN]) == tg, bar);
            __builtin_amdgcn_fence(__ATOMIC_ACQUIRE, "agent");
            xb_add(&bar[XB_XGEN(b.x)], 1u);
            asm volatile("s_waitcnt vmcnt(0)" ::: "memory");
        } else {
            XB_SPIN(xb_ld(&bar[XB_XGEN(b.x)]) == gen, bar);
            __builtin_amdgcn_fence(__ATOMIC_ACQUIRE, "agent");
            asm volatile("s_waitcnt vmcnt(0)" ::: "memory");
        }
    }
    __syncthreads();
}

template <class Sched>
__device__ __forceinline__ void fill_rs_table(LAS float* T, const float* rsp, const Sched& S, int tid) {
    const int half = __builtin_amdgcn_readfirstlane(tid >> 8), lt = tid & 255;
    f32x4 a[8], b[8]; bool ok[8];
#pragma unroll
    for (int j = 0; j < 8; ++j) {
        pg8::Unit u; const int i = 2 * j + half;
        ok[j] = (i < RS_TABLE_UNITS) && S.next(i, u);
        const int pm = ok[j] ? u.pm : 0;
        const GAS float* p = (const GAS float*)rsp + ((size_t)pm * 256 + lt) * 8;
        a[j] = *(const GAS f32x4*)p; b[j] = *(const GAS f32x4*)(p + 4);
    }
#pragma unroll
    for (int j = 0; j < 8; ++j)
        if (ok[j]) T[(2 * j + half) * 256 + lt] = __builtin_amdgcn_rsqf((((a[j][0] + a[j][1]) + (a[j][2] + a[j][3])) + ((b[j][0] + b[j][1]) + (b[j][2] + b[j][3]))) * (1.0f / DM) + EPS);
    __syncthreads();
}

struct Args { const float* in[23]; float* out; unsigned char* ws; float inv[8]; int ph_lo, ph_hi; };

struct ConvJob { const float* W; bf16_t* WT; const float* scale; const float* kscale; int K, N, mode, roff, item; };
constexpr int CI_FF = (DM / 64) * (DFF / 32), CI_Q = (DM / 64) * (512 / 32), CI_WO = (512 / 64) * (DM / 32), CI_IN = (DM / 64) * (INW / 32), CI_OUT = (DM / 64) * (DM / 32), CI_PL = (512 / 64) * (512 / 32);
constexpr int CI_COMMON = 6 * CI_FF + 3 * CI_Q + CI_WO, CI_L0 = CI_COMMON + CI_IN + CI_OUT, CI_L1 = CI_COMMON + 4 * CI_PL;
__device__ __forceinline__ ConvJob conv_decode(const Args& a, int r) {
    int layer = 0; if (r >= CI_L0) { layer = 1; r -= CI_L0; }
    unsigned char* ws = a.ws + WS_WL + (size_t)layer * WL_STRIDE;
    const size_t FW = (size_t)DM * DFF;
    const float* nb = a.in[2] + (size_t)layer * 8 * DM;
    ConvJob j; j.scale = nullptr; j.kscale = nullptr; j.mode = 0; j.roff = 0; j.K = DM; j.N = DFF;
    if (r < CI_FF) { j.W = a.in[4] + layer * FW; j.WT = (bf16_t*)(ws + WO_W1A); j.mode = 1; j.kscale = nb; j.item = r; return j; } r -= CI_FF;
    if (r < CI_FF) { j.W = a.in[5] + layer * FW; j.WT = (bf16_t*)(ws + WO_W1A); j.mode = 2; j.kscale = nb; j.item = r; return j; } r -= CI_FF;
    if (r < CI_FF) { j.W = a.in[6] + layer * FW; j.WT = (bf16_t*)(ws + WO_W1D); j.K = DFF; j.N = DM; j.item = r; return j; } r -= CI_FF;
    if (r < CI_FF) { j.W = a.in[7] + layer * FW; j.WT = (bf16_t*)(ws + WO_W2A); j.mode = 1; j.kscale = nb + 6 * DM; j.item = r; return j; } r -= CI_FF;
    if (r < CI_FF) { j.W = a.in[8] + layer * FW; j.WT = (bf16_t*)(ws + WO_W2A); j.mode = 2; j.kscale = nb + 6 * DM; j.item = r; return j; } r -= CI_FF;
    if (r < CI_FF) { j.W = a.in[9] + layer * FW; j.WT = (bf16_t*)(ws + WO_W2D); j.K = DFF; j.N = DM; j.item = r; return j; } r -= CI_FF;
    j.N = 512;
    if (r < CI_Q) { j.W = a.in[10] + (size_t)layer * DM * 512; j.WT = (bf16_t*)(ws + WO_WQ); j.kscale = nb + 4 * DM; j.item = r; return j; } r -= CI_Q;
    if (r < CI_Q) { j.W = a.in[11] + (size_t)layer * DM * 512; j.WT = (bf16_t*)(ws + WO_WKV); j.item = r; return j; } r -= CI_Q;
    if (r < CI_Q) { j.W = a.in[12] + (size_t)layer * DM * 512; j.WT = (bf16_t*)(ws + WO_WKV); j.roff = 512; j.item = r; return j; } r -= CI_Q;
    if (r < CI_WO) { j.W = a.in[13] + (size_t)layer * 512 * DM; j.WT = (bf16_t*)(ws + WO_WO); j.K = 512; j.N = DM; j.item = r; return j; } r -= CI_WO;
    if (layer == 0) {
        if (r < CI_IN) { j.W = a.in[14]; j.WT = (bf16_t*)(ws + WO_WIN); j.N = INW; j.kscale = nb + 2 * DM; j.item = r; return j; } r -= CI_IN;
        j.W = a.in[15]; j.WT = (bf16_t*)(ws + WO_WOUT); j.N = DM; j.item = r; return j;
    }
    const int gi = r / CI_PL; r -= gi * CI_PL;
    j.W = a.in[21] + (size_t)gi * 512 * 512; j.WT = (bf16_t*)(ws + WO_WPOOL); j.K = 512; j.N = 512; j.roff = gi * 512; j.scale = a.in[22] + gi * 512; j.item = r; return j;
}
__device__ __forceinline__ void conv_load(const ConvJob& j, int lane, float (&v)[32]) {
    const int nblk = j.N / 32, kb = j.item / nblk, nb = j.item % nblk;
    const GAS float* Wg = (const GAS float*)j.W + (size_t)(64 * kb + (lane >> 5)) * j.N + 32 * nb + (lane & 31);
#pragma unroll
    for (int i = 0; i < 32; ++i) v[i] = Wg[(size_t)(2 * i) * j.N];
}
__device__ __forceinline__ void conv_finish(const ConvJob& j, LAS float* scr, int lane, const float (&v)[32]) {
    const int nblk = j.N / 32, kb = j.item / nblk, nb = j.item % nblk, k0 = 64 * kb, n0 = 32 * nb;
    const float sc = j.scale ? ((const GAS float*)j.scale)[n0 + (lane & 31)] : 1.0f;
#pragma unroll
    for (int i = 0; i < 32; ++i) scr[(2 * i + (lane >> 5)) * 33 + (lane & 31)] = v[i] * sc;
    asm volatile("s_waitcnt lgkmcnt(0)" ::: "memory");
    const int drow0 = (j.mode == 0) ? (j.roff + n0) : (256 * (n0 >> 7) + (n0 & 127) + (j.mode == 2 ? 128 : 0));
    const int c = lane & 7;
    f32x4 ka = (f32x4){1.f, 1.f, 1.f, 1.f}, kc = ka;
    if (j.kscale) { ka = *(const GAS f32x4*)((const GAS float*)j.kscale + k0 + 8 * c); kc = *(const GAS f32x4*)((const GAS float*)j.kscale + k0 + 8 * c + 4); }
#pragma unroll
    for (int q = 0; q < 4; ++q) { const int n = (lane >> 3) + 8 * q; const LAS float* s = scr + (8 * c) * 33 + n;
        u32x4 o; o.x = cvt_pk_bf16(s[0 * 33] * ka[0], s[1 * 33] * ka[1]); o.y = cvt_pk_bf16(s[2 * 33] * ka[2], s[3 * 33] * ka[3]); o.z = cvt_pk_bf16(s[4 * 33] * kc[0], s[5 * 33] * kc[1]); o.w = cvt_pk_bf16(s[6 * 33] * kc[2], s[7 * 33] * kc[3]);
        *(GAS u32x4*)((GAS bf16_t*)j.WT + (size_t)(drow0 + n) * j.K + k0 + 8 * c) = o; }
    asm volatile("s_waitcnt lgkmcnt(0)" ::: "memory");
}
__device__ __forceinline__ void conv_all(const Args& a, LAS unsigned char* lds, int wid, int lane, int gw, int ngw) {
    LAS float* scr = (LAS float*)(lds + wid * 16384);
    constexpr int NT = CI_L0 + CI_L1;
    for (int it = gw; it < NT; it += 2 * ngw) {
        const bool h1 = (it + ngw) < NT;
        const ConvJob j0 = conv_decode(a, it), j1 = conv_decode(a, h1 ? it + ngw : it);
        float v0[32], v1[32];
        conv_load(j0, lane, v0); conv_load(j1, lane, v1);
        asm volatile("" ::: "memory");
        conv_finish(j0, scr, lane, v0);
        if (h1) conv_finish(j1, scr, lane, v1);
    }
    for (int layer = 0; layer < 2; ++layer)
        norm_pass(a.in[1], nullptr, nullptr, nullptr, 0.f, nullptr, a.in[3] + layer * DM, (bf16_t*)(a.ws + WS_MEMN + (size_t)layer * 4 * MiB), MEMROWS, gw, ngw, lane);
}

__global__ void __launch_bounds__(512, 2) mega_fwd(Args a) {
    extern __shared__ __attribute__((aligned(16))) unsigned char lds_raw[];
    LAS unsigned char* lds = (LAS unsigned char*)lds_raw;
    cg::grid_group grid = cg::this_grid();
    const int tid = threadIdx.x, lane = tid & 63, wid = __builtin_amdgcn_readfirstlane(tid >> 6);
    const int G = gridDim.x, bx = blockIdx.x;
    const int gw = bx * 8 + wid, ngw = G * 8;
    unsigned char* ws = a.ws;
    bf16_t* Hb = (bf16_t*)(ws + WS_H); float* RS = (float*)(ws + WS_RS);
    bf16_t* HID = (bf16_t*)(ws + WS_HID); bf16_t* Zb = (bf16_t*)(ws + WS_Z); bf16_t* CAT = (bf16_t*)(ws + WS_CAT); bf16_t* POOLB = (bf16_t*)(ws + WS_POOL);
    bf16_t* Qb = (bf16_t*)(ws + WS_Q); bf16_t* Ob = (bf16_t*)(ws + WS_O);
    f32x2* rope = (f32x2*)(ws + WS_ROPE); f32x2* sst = (f32x2*)(ws + WS_SST); bf16_t* SGUW = (bf16_t*)(ws + WS_SGUW);
    const float* norms = a.in[2];
    const int lo = a.ph_lo, hi = a.ph_hi;
    int gp = 0;
    volatile LAS unsigned* MISC = (volatile LAS unsigned*)(lds + LDS_BYTES - 64);
    if (tid < 16) MISC[tid] = 0u;
    __syncthreads();
    XcdBarrier xbar = xcd_barrier_post((unsigned*)ws, MISC);
#define SEAM() do { if (gp + 1 < hi) { if (a.inv[0] < 0.f) grid.sync(); else xcd_barrier(xbar); } } while (0)
#define SEAM_X() do { if (gp + 1 < hi) xcd_barrier(xbar); } while (0)

    if (gp >= lo && gp < hi) {
        prep_pass(a.in[0], Hb, RS, MTOK, gw, ngw, lane);
        conv_all(a, lds, wid, lane, gw, ngw);
        for (int idx = bx * 512 + tid; idx < SEQ * 8; idx += G * 512) {
            const int pos = idx >> 3, k = idx & 7;
            const float ang = (float)pos * a.inv[k];
            double rev = (double)ang * 0.15915494309189535; rev -= floor(rev);
            const float fr = (float)rev;
            ((GAS f32x2*)rope)[idx] = (f32x2){__builtin_amdgcn_cosf(fr), __builtin_amdgcn_sinf(fr)};
        }
        for (int idx = bx * 512 + tid; idx < MTOK * 8; idx += G * 512) ((GAS unsigned long long*)(ws + WS_XB))[idx] = 0ull;
        for (int idx = bx * 512 + tid; idx < 8 * 128 * 128; idx += G * 512) {
            const int i = (idx >> 7) & 127, j = idx & 127;
            const float v = (j <= i) ? ((const GAS float*)a.in[19])[idx] : 0.f;
            ((GAS bf16_t*)SGUW)[idx] = (bf16_t)(cvt_pk_bf16(v, 0.f) & 0xffffu);
        }
        SEAM();
    }
    ++gp;

#pragma unroll 1
    for (int layer = 0; layer < 2; ++layer) {
        const float* gl = norms + layer * 8 * DM;
        const unsigned char* wl = ws + WS_WL + (size_t)layer * WL_STRIDE;
#pragma unroll 1
        for (int p = 0; p < 10; ++p) {
            if ((layer == 1 && p == 3) || p == 6) continue;
            if (gp >= lo && gp < hi) {
                const int tid = fresh_tid(), lane = tid & 63, wid = __builtin_amdgcn_readfirstlane(tid >> 6);
                if (p == 0 || p == 8) {
                    pg8::Gemm g{Hb, (const bf16_t*)(wl + (p == 0 ? WO_W1A : WO_W2A)), MTOK, 2 * DFF, DM, DM, DM, 0, 0u};
                    pg8::StaticOrder S; S.init(MTOK, 2 * DFF, G, bx);
                    fill_rs_table((LAS float*)(lds + XL_OFF), RS, S, tid);
                    pg8::EpiSwiglu E{HID, RS, (const LAS float*)(lds + XL_OFF)};
                    pg8::gemm_phase<pg8::EpiSwiglu, pg8::StaticOrder>(lds, g, S, E);
                } else if (p == 1 || p == 9 || p == 4 || p == 7) {
                    pg8::Gemm g;
                    if (p == 1 || p == 9) g = pg8::Gemm{HID, (const bf16_t*)(wl + (p == 1 ? WO_W1D : WO_W2D)), MTOK, DM, DFF, DFF, DFF, 0, 0u};
                    else if (p == 7) g = pg8::Gemm{Ob, (const bf16_t*)(wl + WO_WO), MTOK, DM, 512, 512, 512, 0, 0u};
                    else if (layer == 0) g = pg8::Gemm{CAT, (const bf16_t*)(wl + WO_WOUT), MTOK, DM, DM, DM, DM, 0, 0u};
                    else g = pg8::Gemm{POOLB, (const bf16_t*)(wl + WO_WPOOL), MTOK, DM, 512, DM, 512, 1, 1024u};
                    const int gi = (p == 1) ? 1 : (p == 4) ? 3 : (p == 7) ? 5 : 7;
                    const int seq = layer * 4 + (gi >> 1);
                    const bool final_ = (p == 9 && layer == 1);
                    pg8::PanelOrder S; S.init(MTOK, G, bx);
                    pg8::EpiNorm E{Hb, final_ ? a.out : nullptr, RS, gl + gi * DM, (p == 1 || p == 9) ? 0.5f : 1.0f,
                                   (float*)(ws + WS_XB), (unsigned*)(ws + WS_CNT), (unsigned)(seq + 1), lds + XL_OFF};
                    pg8::gemm_phase<pg8::EpiNorm, pg8::PanelOrder>(lds, g, S, E);
                } else if (p == 2) {
                    if (layer == 0) {
                        pg8::Gemm g{Hb, (const bf16_t*)(wl + WO_WIN), MTOK, INW, DM, DM, DM, 0, 0u};
                        pg8::StaticOrder S; S.init(MTOK, INW, G, bx);
                        fill_rs_table((LAS float*)(lds + XL_OFF), RS, S, tid);
                        pg8::EpiAct E{Zb, INW, 5, 9, sst, RS, (const LAS float*)(lds + XL_OFF)};
                        for (int k = 0; k < 3; ++k) {
                            if (k > 0) {
                                const unsigned char* wk = ws + WS_WL + (size_t)(k - 1) * WL_STRIDE;
                                g = pg8::Gemm{(const bf16_t*)(ws + WS_MEMN + (size_t)(k - 1) * 4 * MiB), (const bf16_t*)(wk + WO_WKV), MEMROWS, 1024, DM, DM, DM, 0, 0u};
                                S.init(MEMROWS, 1024, G, G > 96 ? (bx + G - 64 - 16 * (k - 1)) % G : bx);
                                E = pg8::EpiAct{(bf16_t*)(ws + WS_KV + (size_t)(k - 1) * 2 * MiB), 1024, 1 << 30, 1 << 30, sst, nullptr, nullptr};
                            }
                            pg8::gemm_phase<pg8::EpiAct, pg8::StaticOrder>(lds, g, S, E);
                        }
                    } else {
                        for (int u = bx; u < MTOK / 32; u += G) pool_unit(lds, Hb, RS, gl + 2 * DM, POOLB, u, tid);
                    }
                } else if (p == 3) {
                    for (int u = bx; u < 256 + 1024; u += G) {
                        if (u < 256) attn_unit(lds, Zb, CAT, rope, a.in[16], u, tid, wid, lane);
                        else sgu_unit(lds, Zb, CAT, sst, SGUW, a.in[17], a.in[18], a.in[20], u - 256, tid, wid, lane);
                    }
                } else if (p == 5) {
                    pg8::Gemm g{Hb, (const bf16_t*)(wl + WO_WQ), MTOK, 512, DM, DM, DM, 0, 0u};
                    pg8::StaticOrder S; S.init(MTOK, 1024, G, bx);
                    fill_rs_table((LAS float*)(lds + XL_OFF), RS, S, tid);
                    pg8::EpiHalf E{Qb, 512, RS, (const LAS float*)(lds + XL_OFF)};
                    pg8::gemm_phase<pg8::EpiHalf, pg8::StaticOrder, true>(lds, g, S, E);
                    const bf16_t* kvl = (const bf16_t*)(ws + WS_KV + (size_t)layer * 2 * MiB);
                    pg8::Unit u;
                    for (int i = 0; S.next(i, u); ++i) xattn_unit(lds, Qb, kvl, Ob, ((u.pm >> 4) * 4 + u.pn) * 16 + (u.pm & 15), tid, wid, lane);
                }
                if (!(layer == 1 && p == 9)) SEAM_X();
            }
            ++gp;
        }
    }
#undef SEAM
#undef SEAM_X
}

extern "C" void kernel_launch(void* const* d_in, const int* in_sizes, int n_in, void* d_out, int out_size, void* d_ws, size_t ws_size, hipStream_t stream) {
    static int grid = 0;
    if (grid == 0) {
        if (n_in != 23 || out_size != MTOK * DM || ws_size < WS_END) { fprintf(stderr, "kernel_launch: unexpected problem (n_in %d, out %d, ws %zu)\n", n_in, out_size, ws_size); grid = -1; return; }
        int dev = 0, cus = 0, per_cu = 0;
        hipGetDevice(&dev);
        hipDeviceGetAttribute(&cus, hipDeviceAttributeMultiprocessorCount, dev);
        if (hipFuncSetAttribute((const void*)mega_fwd, hipFuncAttributeMaxDynamicSharedMemorySize, LDS_BYTES) != hipSuccess) { fprintf(stderr, "kernel_launch: hipFuncSetAttribute failed\n"); grid = -1; return; }
        if (hipOccupancyMaxActiveBlocksPerMultiprocessor(&per_cu, (const void*)mega_fwd, 512, LDS_BYTES) != hipSuccess || per_cu < 1) { fprintf(stderr, "kernel_launch: occupancy query gave %d\n", per_cu); per_cu = 1; }
        (void)hipGetLastError();
        grid = cus * per_cu; grid -= grid % 8;
        fprintf(stderr, "kernel_launch: grid %d (cus %d x %d)\n", grid, cus, per_cu);
    }
    if (grid < 0) return;
    if (hipMemsetAsync(d_ws, 0, 65536, stream) != hipSuccess) { fprintf(stderr, "kernel_launch: memset failed\n"); return; }
    Args a{};
    for (int i = 0; i < 23; ++i) a.in[i] = (const float*)d_in[i];
    a.out = (float*)d_out; a.ws = (unsigned char*)d_ws;
    for (int k = 0; k < 8; ++k) a.inv[k] = (float)pow(500000.0, -(double)k / 8.0);
    a.ph_lo = 0; a.ph_hi = 1000;
    void* args[] = {&a};
    hipError_t e = hipLaunchCooperativeKernel((const void*)mega_fwd, dim3(grid), dim3(512), args, LDS_BYTES, stream);
    if (e != hipSuccess) fprintf(stderr, "kernel_launch: cooperative launch failed: %s (grid %d)\n", hipGetErrorString(e), grid);
}
```
